# Optimizing an MI355X kernel written in HIP

```python
import jax, jax.numpy as jnp
from jax import lax
import numpy as np

D_MODEL = 2048
BATCH = 4
SEQ = 2048
DEPTH = 4

HEAD_DIM = 64
N_HEADS_A = 16
N_HEADS_B = 16
N_KV_B = 2
REP_B = N_HEADS_B // N_KV_B
D_A = N_HEADS_A * HEAD_DIM
D_B = N_HEADS_B * HEAD_DIM
D_KV_B = N_KV_B * HEAD_DIM
D_MIX = D_A + D_B
IN_COLS = 3 * D_A + D_B + 2 * D_KV_B
N_ALIBI = N_HEADS_A + N_HEADS_B
DILATED_CFG = ((128, 1), (512, 4), (2048, 16))
SWA_WINDOW = 128
BLK = 128
D_FF = -(-(8 * D_MODEL) // (3 * 256)) * 256
EPS = 1e-6

kernel_name = "hybrid_dilated_swa_sink_alibi"


def rmsnorm(x, g):
    xf = x.astype(jnp.float32)
    y = xf * lax.rsqrt(jnp.mean(xf * xf, axis=-1, keepdims=True) + EPS)
    return (y * g.astype(jnp.float32)).astype(x.dtype)


def alibi_slopes():
    idx = jnp.arange(N_ALIBI, dtype=jnp.float32)
    s = jnp.exp2(-8.0 * (idx + 1.0) / N_ALIBI)
    return s[0::2], s[1::2]


def banded_parts(q, k, v, slopes, max_dist, pos_scale):
    n, g, r, L, dh = q.shape
    nb = -(-L // BLK)
    pad = nb * BLK - L
    q = jnp.pad(q, ((0, 0), (0, 0), (0, 0), (0, pad), (0, 0)))
    k = jnp.pad(k, ((0, 0), (0, 0), (BLK, pad), (0, 0)))
    v = jnp.pad(v, ((0, 0), (0, 0), (BLK, pad), (0, 0)))
    qb = q.reshape(n, g, r, nb, BLK, dh)
    kb = k.reshape(n, g, nb + 1, BLK, dh)
    vb = v.reshape(n, g, nb + 1, BLK, dh)
    kw = jnp.concatenate([kb[:, :, :-1], kb[:, :, 1:]], axis=3)
    vw = jnp.concatenate([vb[:, :, :-1], vb[:, :, 1:]], axis=3)
    scores = jnp.einsum('ngrbqd,ngbkd->ngrbqk', qb, kw).astype(jnp.float32) * (dh ** -0.5)
    qi = jnp.arange(BLK)[:, None]
    ki = jnp.arange(2 * BLK)[None, :]
    dist = qi + BLK - ki
    key_pos = jnp.arange(nb)[:, None, None] * BLK + ki[None] - BLK
    valid = (dist >= 0) & (dist <= max_dist) & (key_pos >= 0)
    bias = -slopes.astype(jnp.float32)[:, :, None, None, None] * (dist * pos_scale).astype(jnp.float32)
    logits = jnp.where(valid, scores + bias, -jnp.inf)
    m = jnp.max(logits, axis=-1, keepdims=True)
    p = jnp.exp(logits - m)
    s = jnp.sum(p, axis=-1, keepdims=True)
    num = jnp.einsum('ngrbqk,ngbkd->ngrbqd', p, vw.astype(jnp.float32))
    num = num.reshape(n, g, r, nb * BLK, dh)[:, :, :, :L]
    m = m.reshape(n, g, r, nb * BLK, 1)[:, :, :, :L]
    s = s.reshape(n, g, r, nb * BLK, 1)[:, :, :, :L]
    return num, m, s


def dilated_attention(q, k, v, slopes):
    b, h, s_len, dh = q.shape
    nums, ms, ss = [], [], []
    for window, d in DILATED_CFG:
        ls = s_len // d

        def to_sub(t):
            return t.reshape(b, h, ls, d, dh).transpose(3, 0, 1, 2, 4).reshape(d * b, h, ls, dh)

        def from_sub(t):
            c = t.shape[-1]
            return t[:, :, 0].reshape(d, b, h, ls, c).transpose(1, 2, 3, 0, 4).reshape(b, h, s_len, c)

        num, m, sm = banded_parts(to_sub(q)[:, :, None], to_sub(k), to_sub(v),
                                  slopes[:, None], window // d, d)
        nums.append(from_sub(num))
        ms.append(from_sub(m))
        ss.append(from_sub(sm))
    m_all = jnp.maximum(jnp.maximum(ms[0], ms[1]), ms[2])
    w = [jnp.exp(mi - m_all) for mi in ms]
    numer = nums[0] * w[0] + nums[1] * w[1] + nums[2] * w[2]
    denom = ss[0] * w[0] + ss[1] * w[1] + ss[2] * w[2]
    return numer / denom


def swa_sink_attention(q, k, v, slopes, sinks):
    num, m, s = banded_parts(q, k, v, slopes, SWA_WINDOW - 1, 1)
    sink = sinks.astype(jnp.float32)[None, :, :, None, None]
    m2 = jnp.maximum(m, sink)
    c = jnp.exp(m - m2)
    return (num * c) / (s * c + jnp.exp(sink - m2))


def setup_inputs(seed: int = 0) -> dict:
    key = jax.random.key(seed)
    ks = jax.random.split(key, 12)
    f32 = jnp.float32
    x = jax.random.normal(ks[0], (BATCH, SEQ, D_MODEL), f32)
    attn_norm = 1.0 + 0.05 * jax.random.normal(ks[1], (DEPTH, D_MODEL), f32)
    w_in = jax.random.normal(ks[2], (DEPTH, D_MODEL, IN_COLS), f32) * D_MODEL ** -0.5
    sinks = 0.5 * jax.random.normal(ks[3], (DEPTH, N_HEADS_B), f32)
    out_norm_a = 1.0 + 0.05 * jax.random.normal(ks[4], (DEPTH, D_A), f32)
    out_norm_b = 1.0 + 0.05 * jax.random.normal(ks[5], (DEPTH, D_B), f32)
    w_out = jax.random.normal(ks[6], (DEPTH, D_MIX, D_MODEL), f32) * D_MIX ** -0.5
    ffn_norm = 1.0 + 0.05 * jax.random.normal(ks[7], (DEPTH, D_MODEL), f32)
    w_gate = jax.random.normal(ks[8], (DEPTH, D_MODEL, D_FF), f32) * D_MODEL ** -0.5
    w_up = jax.random.normal(ks[9], (DEPTH, D_MODEL, D_FF), f32) * D_MODEL ** -0.5
    w_down = jax.random.normal(ks[10], (DEPTH, D_FF, D_MODEL), f32) * D_FF ** -0.5
    final_norm = 1.0 + 0.05 * jax.random.normal(ks[11], (D_MODEL,), f32)
    return {"x": x, "attn_norm": attn_norm, "w_in": w_in, "sinks": sinks,
            "out_norm_a": out_norm_a, "out_norm_b": out_norm_b, "w_out": w_out,
            "ffn_norm": ffn_norm, "w_gate": w_gate, "w_up": w_up, "w_down": w_down,
            "final_norm": final_norm}


def reference(x, attn_norm, w_in, sinks, out_norm_a, out_norm_b, w_out,
              ffn_norm, w_gate, w_up, w_down, final_norm):
    b, s_len, _ = x.shape
    slopes_a, slopes_b = alibi_slopes()
    slopes_b = slopes_b.reshape(N_KV_B, REP_B)
    for l in range(DEPTH):
        h = rmsnorm(x, attn_norm[l])
        proj = jnp.einsum('bsd,de->bse', h, w_in[l])
        c0, c1, c2 = D_A, 2 * D_A, 3 * D_A
        c3, c4 = c2 + D_B, c2 + D_B + D_KV_B
        qa = proj[..., :c0].reshape(b, s_len, N_HEADS_A, HEAD_DIM).transpose(0, 2, 1, 3)
        ka = proj[..., c0:c1].reshape(b, s_len, N_HEADS_A, HEAD_DIM).transpose(0, 2, 1, 3)
        va = proj[..., c1:c2].reshape(b, s_len, N_HEADS_A, HEAD_DIM).transpose(0, 2, 1, 3)
        qb = proj[..., c2:c3].reshape(b, s_len, N_KV_B, REP_B, HEAD_DIM).transpose(0, 2, 3, 1, 4)
        kb = proj[..., c3:c4].reshape(b, s_len, N_KV_B, HEAD_DIM).transpose(0, 2, 1, 3)
        vb = proj[..., c4:].reshape(b, s_len, N_KV_B, HEAD_DIM).transpose(0, 2, 1, 3)

        out_a = dilated_attention(qa, ka, va, slopes_a)
        out_a = out_a.transpose(0, 2, 1, 3).reshape(b, s_len, D_A).astype(x.dtype)
        out_b = swa_sink_attention(qb, kb, vb, slopes_b, sinks[l].reshape(N_KV_B, REP_B))
        out_b = out_b.transpose(0, 3, 1, 2, 4).reshape(b, s_len, D_B).astype(x.dtype)
        mix = jnp.concatenate([rmsnorm(out_a, out_norm_a[l]),
                               rmsnorm(out_b, out_norm_b[l])], axis=-1)
        x = x + jnp.einsum('bse,ed->bsd', mix, w_out[l])
        h = rmsnorm(x, ffn_norm[l])
        gate = jnp.einsum('bsd,df->bsf', h, w_gate[l])
        up = jnp.einsum('bsd,df->bsf', h, w_up[l])
        x = x + jnp.einsum('bsf,fd->bsd', jax.nn.silu(gate) * up, w_down[l])
    return rmsnorm(x, final_norm)
```

```cpp
#include <hip/hip_runtime.h>
#include <hip/hip_cooperative_groups.h>
#include <cstdio>
#include <cstdint>
namespace cg = cooperative_groups;
namespace pg8 {
#define PG8_LAS __attribute__((address_space(3)))
typedef unsigned short bf16_t;
typedef short bf16x8 __attribute__((ext_vector_type(8)));
typedef float f32x4 __attribute__((ext_vector_type(4)));
typedef unsigned u32x4 __attribute__((ext_vector_type(4)));
constexpr int BM = 256, BK = 64, HALF = 128, HTB = HALF * BK * 2  , STAGE_BYTES = 8 * HTB, NXCD = 8, WGM = 8;

__host__ __device__ __forceinline__ int lds_byte(int r, int c) { const int st = (r >> 4) * 2 + (c >> 5), rr = r & 15, cc = c & 31, ob = rr * 64 + cc * 2; return st * 1024 + (ob ^ (((ob >> 9) & 1) << 5)); }
__host__ __device__ __forceinline__ void stage_rc(int b, int& R, int& C) { const int st = b / 1024, sb = b % 1024, swz = sb ^ (((sb >> 9) & 1) << 5); R = (st >> 1) * 16 + swz / 64; C = (st & 1) * 32 + (swz % 64) / 2; }
__host__ __device__ __forceinline__ int perm32(int rho) { const int n = rho >> 4, i = rho & 15; return 8 * (i >> 2) + 4 * n + (i & 3); }

struct Unit { int pm, pn; };
struct Gemm { const bf16_t* A; const bf16_t* Bt; int M, N, K; };

struct StaticOrder {
    int nM, nN, nwg, G, c;
    __host__ __device__ void init(int M, int N, int G_, int c_) { nM = M / BM; nN = N / BM; nwg = nM * nN; G = G_; c = c_; }
    __host__ __device__ bool next(int i, Unit& u) const {
        const long L = (long)i * G + c; if (L >= nwg) return false;
        int wgid = (int)L; { const int q = nwg / NXCD, r = nwg % NXCD, xcd = wgid % NXCD, off = wgid / NXCD; wgid = (xcd < r ? xcd * (q + 1) : r * (q + 1) + (xcd - r) * q) + off; }
        const int nig = WGM * nN, gid = wgid / nig, fm = gid * WGM, gsz = (nM - fm) < WGM ? (nM - fm) : WGM;
        u.pm = fm + ((wgid % nig) % gsz); u.pn = (wgid % nig) / gsz; return true;
    }
    __device__ __forceinline__ void a_ready(const Unit&) const {}
    __device__ __forceinline__ void done(const Unit&) const {}
};

__device__ __forceinline__ unsigned cvt_pk_bf16(float lo, float hi) { unsigned r; asm volatile("v_cvt_pk_bf16_f32 %0, %1, %2" : "=v"(r) : "v"(lo), "v"(hi)); return r; }
typedef float f32x2 __attribute__((ext_vector_type(2)));
template <class Epi, class Sched, bool ALIGN_EPI = false, bool SP2 = false>
__device__ __forceinline__ void gemm_phase(PG8_LAS unsigned char* lds, const Gemm g, const Sched& S, const Epi& E) {
    int tid_l = threadIdx.x; asm volatile("" : "+v"(tid_l));
    const int tid = tid_l, wid = __builtin_amdgcn_readfirstlane(tid >> 6), lane = tid & 63, wr = wid >> 2, wc = wid & 3, fr = lane & 15, fq = lane >> 4;
    const int K = g.K, nt = K / BK;
    unsigned voffA[2], voffB[2];
#pragma unroll
    for (int i = 0; i < 2; ++i) { int R, C; stage_rc(tid * 16 + i * 8192, R, C); const int Rb = Epi::PERM ? ((R & ~31) + perm32(R & 31)) : R;
        voffA[i] = (unsigned)(R * K + C) * 2u; voffB[i] = (unsigned)(Rb * K + C) * 2u; }
    const size_t kstep = (size_t)(BK * 2);
    const size_t hstep = (size_t)HALF * K * 2;
    const size_t tstep = 2 * hstep;
    const unsigned ldsw = (unsigned)wid * 1024u;
    const int aoff = lds_byte(wr * 64 + fr, fq * 8), boff = lds_byte(wc * 32 + fr, fq * 8);
#define PG8_SA(b, h) (((b) * 2 + (h)) * HTB)
#define PG8_SB(b, h) ((4 + (b) * 2 + (h)) * HTB)
#define PG8_STAGE(bufoff, gbase, voff) do { _Pragma("unroll") for (int _i = 0; _i < 2; ++_i) \
        __builtin_amdgcn_global_load_lds((const unsigned*)((const char*)(gbase) + (voff)[_i]), (PG8_LAS unsigned*)(lds + (bufoff) + ldsw + _i * 8192), 16, 0, 0); } while (0)
#define PG8_LDA(dst, b, h) do { _Pragma("unroll") for (int m = 0; m < 4; ++m) _Pragma("unroll") for (int k = 0; k < 2; ++k) dst[m][k] = *(const PG8_LAS bf16x8*)(lds + PG8_SA(b, h) + aoff + m * 2048 + k * 1024); } while (0)
#define PG8_LDB(dst, b, h) do { _Pragma("unroll") for (int n = 0; n < 2; ++n) _Pragma("unroll") for (int k = 0; k < 2; ++k) dst[n][k] = *(const PG8_LAS bf16x8*)(lds + PG8_SB(b, h) + boff + n * 2048 + k * 1024); } while (0)
#define PG8_MMA(ai, bj, At, Bt) do { __builtin_amdgcn_s_setprio(1); _Pragma("unroll") for (int m = 0; m < 4; ++m) _Pragma("unroll") for (int n = 0; n < 2; ++n) _Pragma("unroll") for (int k = 0; k < 2; ++k) \
        acc[ai][bj][m][n] = __builtin_amdgcn_mfma_f32_16x16x32_bf16(Bt[n][k], At[m][k], acc[ai][bj][m][n], 0, 0, 0); __builtin_amdgcn_s_setprio(0); } while (0)
#define PG8_WAIT_V(n) asm volatile("s_waitcnt vmcnt(" #n ")" ::: "memory")
#define PG8_WAIT_L(n) asm volatile("s_waitcnt lgkmcnt(" #n ")" ::: "memory")
#define PG8_BAR __builtin_amdgcn_s_barrier()
#define PG8_SCHED __builtin_amdgcn_sched_barrier(0)
    Unit cur, nxt; int ui = 0;
    if (!S.next(0, cur)) return;
    f32x4 acc[2][2][4][2];
#pragma unroll
    for (int a = 0; a < 2; ++a)
#pragma unroll
        for (int b = 0; b < 2; ++b)
#pragma unroll
            for (int m = 0; m < 4; ++m)
#pragma unroll
                for (int n = 0; n < 2; ++n) acc[a][b][m][n] = (f32x4){0.f, 0.f, 0.f, 0.f};
    bf16x8 At[4][2], B0[2][2], B1[2][2];
    const char* cA = (const char*)g.A + (size_t)cur.pm * tstep; const char* cB = (const char*)g.Bt + (size_t)cur.pn * tstep;
    S.a_ready(cur);
    if constexpr (SP2) {
        PG8_STAGE(PG8_SB(0, 0), cB, voffB); PG8_STAGE(PG8_SB(0, 1), cB + hstep, voffB); PG8_STAGE(PG8_SA(0, 0), cA, voffA); PG8_STAGE(PG8_SA(0, 1), cA + hstep, voffA);
        if (wr == 1) PG8_BAR;
        PG8_WAIT_V(2); PG8_BAR;
        PG8_STAGE(PG8_SB(1, 0), cB + kstep, voffB); PG8_STAGE(PG8_SA(1, 0), cA + kstep, voffA); PG8_STAGE(PG8_SB(1, 1), cB + hstep + kstep, voffB);
        PG8_WAIT_V(6); PG8_BAR;
    } else {
        PG8_STAGE(PG8_SB(0, 0), cB, voffB); PG8_STAGE(PG8_SA(0, 0), cA, voffA); PG8_STAGE(PG8_SB(0, 1), cB + hstep, voffB); PG8_STAGE(PG8_SA(0, 1), cA + hstep, voffA);
        if (wr == 1) PG8_BAR;
        PG8_WAIT_V(4); PG8_BAR;
        PG8_STAGE(PG8_SB(1, 0), cB + kstep, voffB); PG8_STAGE(PG8_SA(1, 0), cA + kstep, voffA); PG8_STAGE(PG8_SB(1, 1), cB + hstep + kstep, voffB);
        PG8_WAIT_V(6); PG8_BAR;
    }
    for (;;) {
        const bool has_next = S.next(ui + 1, nxt);
        const char* nA = has_next ? (const char*)g.A + (size_t)nxt.pm * tstep : cA; const char* nB = has_next ? (const char*)g.Bt + (size_t)nxt.pn * tstep : cB;
        for (int t = 0; t < nt; t += 2) {
            const bool last = (t == nt - 2);
            const char* a1 = cA + (size_t)(t + 1) * kstep;
            const char* a2 = last ? nA : cA + (size_t)(t + 2) * kstep; const char* b2 = last ? nB : cB + (size_t)(t + 2) * kstep;
            const char* a3 = a2 + kstep; const char* b3 = b2 + kstep;
            if (last && has_next) S.a_ready(nxt);
            if constexpr (SP2) {
            PG8_LDB(B0, 0, 0); PG8_LDB(B1, 0, 1); PG8_SCHED; PG8_LDA(At, 0, 0); PG8_STAGE(PG8_SA(1, 1), a1 + hstep, voffA);
            PG8_WAIT_V(8); PG8_WAIT_L(0); PG8_BAR; PG8_MMA(0, 0, At, B0); PG8_MMA(0, 1, At, B1); PG8_BAR; PG8_SCHED;
            PG8_LDA(At, 0, 1); PG8_STAGE(PG8_SB(0, 0), b2, voffB); PG8_STAGE(PG8_SB(0, 1), b2 + hstep, voffB); PG8_STAGE(PG8_SA(0, 0), a2, voffA);
            PG8_WAIT_V(8); PG8_WAIT_L(0); PG8_BAR; PG8_MMA(1, 0, At, B0); PG8_MMA(1, 1, At, B1); PG8_BAR; PG8_SCHED;
            PG8_LDB(B0, 1, 0); PG8_LDB(B1, 1, 1); PG8_SCHED; PG8_LDA(At, 1, 0); PG8_STAGE(PG8_SA(0, 1), a2 + hstep, voffA);
            PG8_WAIT_V(8); PG8_WAIT_L(0); PG8_BAR; PG8_MMA(0, 0, At, B0); PG8_MMA(0, 1, At, B1); PG8_BAR; PG8_SCHED;
            PG8_LDA(At, 1, 1); PG8_STAGE(PG8_SB(1, 0), b3, voffB); PG8_STAGE(PG8_SB(1, 1), b3 + hstep, voffB); PG8_STAGE(PG8_SA(1, 0), a3, voffA);
            PG8_WAIT_V(8); PG8_WAIT_L(0); PG8_BAR; PG8_MMA(1, 0, At, B0); PG8_MMA(1, 1, At, B1); PG8_BAR; PG8_SCHED;
            } else {
            PG8_LDB(B0, 0, 0); PG8_SCHED; PG8_LDA(At, 0, 0); PG8_STAGE(PG8_SA(1, 1), a1 + hstep, voffA);
            PG8_WAIT_L(8); PG8_BAR; PG8_WAIT_L(0); PG8_MMA(0, 0, At, B0); PG8_BAR; PG8_SCHED;
            PG8_LDB(B1, 0, 1); PG8_STAGE(PG8_SB(0, 0), b2, voffB);
            PG8_BAR; PG8_WAIT_L(0); PG8_MMA(0, 1, At, B1); PG8_BAR;
            PG8_LDA(At, 0, 1); PG8_STAGE(PG8_SA(0, 0), a2, voffA);
            PG8_BAR; PG8_WAIT_L(0); PG8_MMA(1, 0, At, B0); PG8_BAR; PG8_SCHED;
            PG8_STAGE(PG8_SB(0, 1), b2 + hstep, voffB);
            PG8_WAIT_V(6); PG8_BAR; PG8_MMA(1, 1, At, B1); PG8_BAR;
            PG8_LDB(B0, 1, 0); PG8_SCHED; PG8_LDA(At, 1, 0); PG8_STAGE(PG8_SA(0, 1), a2 + hstep, voffA);
            PG8_WAIT_L(8); PG8_BAR; PG8_WAIT_L(0); PG8_MMA(0, 0, At, B0); PG8_BAR; PG8_SCHED;
            PG8_LDB(B1, 1, 1); PG8_STAGE(PG8_SB(1, 0), b3, voffB);
            PG8_BAR; PG8_WAIT_L(0); PG8_MMA(0, 1, At, B1); PG8_BAR;
            PG8_LDA(At, 1, 1); PG8_STAGE(PG8_SA(1, 0), a3, voffA);
            PG8_BAR; PG8_WAIT_L(0); PG8_MMA(1, 0, At, B0); PG8_BAR; PG8_SCHED;
            PG8_STAGE(PG8_SB(1, 1), b3 + hstep, voffB);
            PG8_WAIT_V(6); PG8_BAR; PG8_MMA(1, 1, At, B1); PG8_BAR;
            }
        }
        if constexpr (ALIGN_EPI) { if (wr == 0) PG8_BAR; }
        if constexpr (!Epi::AFTER_DRAIN) { E(acc, cur, wr, wc, fr, fq); S.done(cur); }
        if (!has_next) break;
#pragma unroll
        for (int a = 0; a < 2; ++a)
#pragma unroll
            for (int b = 0; b < 2; ++b)
#pragma unroll
                for (int m = 0; m < 4; ++m)
#pragma unroll
                    for (int n = 0; n < 2; ++n) acc[a][b][m][n] = (f32x4){0.f, 0.f, 0.f, 0.f};
        cur = nxt; cA = nA; cB = nB; ++ui;
        if constexpr (ALIGN_EPI) { if (wr == 1) PG8_BAR; }
    }
    PG8_WAIT_V(0);
    if constexpr (!ALIGN_EPI) { if (wr == 0) PG8_BAR; }
    PG8_BAR;
    if constexpr (Epi::AFTER_DRAIN) { E.fused(acc, cur, wr, wc, fr, fq, lds, wid, lane); S.done(cur); }
#undef PG8_SA
#undef PG8_SB
#undef PG8_STAGE
#undef PG8_LDA
#undef PG8_LDB
#undef PG8_MMA
#undef PG8_WAIT_V
#undef PG8_WAIT_L
#undef PG8_BAR
#undef PG8_SCHED
}
}

#define LAS __attribute__((address_space(3)))
typedef unsigned short bf16;
typedef unsigned v4u __attribute__((ext_vector_type(4)));
typedef unsigned v2u __attribute__((ext_vector_type(2)));
typedef float f32x4 __attribute__((ext_vector_type(4)));
typedef short bf16x8 __attribute__((ext_vector_type(8)));
typedef short v4i16_t __attribute__((ext_vector_type(4)));

constexpr int BATCH = 4, SEQ = 2048, DM = 2048, DEPTH = 4;
constexpr int T = BATCH * SEQ;
constexpr int IN_COLS = 4352, DFF = 5632, NGU = 2 * DFF;
constexpr int C_QA = 0, C_KA = 1024, C_VA = 2048, C_QB = 3072, C_KB = 4096, C_VB = 4224;
constexpr float EPS = 1e-6f, LOG2E = 1.4426950408889634f;
constexpr int NWAVES = 8, NTHREADS = 512;
constexpr int LDS_BYTES = 136 * 1024;

constexpr size_t SZ_WIN = (size_t)IN_COLS * DM * 2, SZ_WOUT = (size_t)DM * DM * 2, SZ_WGU = (size_t)NGU * DM * 2, SZ_WDN = (size_t)DM * DFF * 2;
constexpr size_t WS_WIN = 0;
constexpr size_t WS_WOUT = WS_WIN + DEPTH * SZ_WIN;
constexpr size_t WS_WGU = WS_WOUT + DEPTH * SZ_WOUT;
constexpr size_t WS_WDN = WS_WGU + DEPTH * SZ_WGU;
constexpr size_t WS_XB = WS_WDN + DEPTH * SZ_WDN;
constexpr size_t WS_PROJ = WS_XB + (size_t)T * DM * 2;
constexpr size_t WS_OA = WS_PROJ + (size_t)T * IN_COLS * 2;
constexpr size_t WS_OB = WS_OA + 3 * (size_t)T * 1024 * 2;
constexpr size_t WS_MIX = WS_OB + (size_t)T * 1024 * 2;
constexpr size_t WS_ACT = WS_MIX + (size_t)T * DM * 2;
constexpr size_t WS_SSQ = WS_ACT + (size_t)T * DFF * 2;
constexpr size_t WS_MA = WS_SSQ + (size_t)T * 32 * 4;
constexpr size_t WS_LA = WS_MA + 3 * (size_t)T * 16 * 4;
constexpr size_t WS_END = WS_LA + 3 * (size_t)T * 16 * 4;

#define LDS_WAIT() asm volatile("s_waitcnt lgkmcnt(0)" ::: "memory")
__device__ __forceinline__ unsigned pkbf(float lo, float hi) { return pg8::cvt_pk_bf16(lo, hi); }
__device__ __forceinline__ float wave_sum(float v) {
#pragma unroll
    for (int o = 1; o < 64; o <<= 1) v += __shfl_xor(v, o);
    return v;
}
__device__ __forceinline__ float dot4(f32x4 v) { return (v[0] * v[0] + v[1] * v[1]) + (v[2] * v[2] + v[3] * v[3]); }

__device__ __forceinline__ float row_rstd(const float* ssq, int row, int fq) {
    const f32x4 a = *(const f32x4*)(ssq + (size_t)row * 32 + 8 * fq), b = *(const f32x4*)(ssq + (size_t)row * 32 + 8 * fq + 4);
    float s = ((a[0] + a[1]) + (a[2] + a[3])) + ((b[0] + b[1]) + (b[2] + b[3]));
    s += __shfl_xor(s, 16); s += __shfl_xor(s, 32);
    return __builtin_amdgcn_rsqf(s * (1.0f / DM) + EPS);
}
struct EpiScaleBf16 {
    static constexpr bool PERM = true, AFTER_DRAIN = false;
    bf16* O; int ldc; const float* ssq;
    __device__ __forceinline__ void operator()(const pg8::f32x4 (&acc)[2][2][4][2], const pg8::Unit& u, int wr, int wc, int fr, int fq) const {
        const int row0 = u.pm * 256 + wr * 64 + fr, col0 = u.pn * 256 + wc * 32 + 8 * fq;
#pragma unroll
        for (int ai = 0; ai < 2; ++ai)
#pragma unroll
            for (int m = 0; m < 4; ++m) {
                const int row = row0 + ai * 128 + m * 16; const float rs = row_rstd(ssq, row, fq); bf16* rowp = O + (size_t)row * ldc + col0;
#pragma unroll
                for (int bj = 0; bj < 2; ++bj) { const f32x4 v0 = acc[ai][bj][m][0] * rs, v1 = acc[ai][bj][m][1] * rs;
                    v4u w; w.x = pkbf(v0[0], v0[1]); w.y = pkbf(v0[2], v0[3]); w.z = pkbf(v1[0], v1[1]); w.w = pkbf(v1[2], v1[3]);
                    *(v4u*)(rowp + bj * 128) = w; }
            }
    }
};
struct EpiSwiglu {
    static constexpr bool PERM = true, AFTER_DRAIN = false;
    bf16* O; const float* ssq;
    __device__ __forceinline__ void operator()(const pg8::f32x4 (&acc)[2][2][4][2], const pg8::Unit& u, int wr, int wc, int fr, int fq) const {
        const int row0 = u.pm * 256 + wr * 64 + fr, col0 = u.pn * 128 + wc * 32 + 8 * fq;
#pragma unroll
        for (int ai = 0; ai < 2; ++ai)
#pragma unroll
            for (int m = 0; m < 4; ++m) {
                const int row = row0 + ai * 128 + m * 16; const float rs = row_rstd(ssq, row, fq);
                float a[8];
#pragma unroll
                for (int n = 0; n < 2; ++n)
#pragma unroll
                    for (int k = 0; k < 4; ++k) { const float g = acc[ai][0][m][n][k] * rs, up = acc[ai][1][m][n][k] * rs;
                        a[n * 4 + k] = g * __builtin_amdgcn_rcpf(1.0f + __builtin_amdgcn_exp2f(-g * LOG2E)) * up; }
                v4u w; w.x = pkbf(a[0], a[1]); w.y = pkbf(a[2], a[3]); w.z = pkbf(a[4], a[5]); w.w = pkbf(a[6], a[7]);
                *(v4u*)(O + (size_t)row * DFF + col0) = w;
            }
    }
};
struct EpiResid {
    static constexpr bool PERM = false, AFTER_DRAIN = false;
    float* x; bf16* xb; float* ssq;
    __device__ __forceinline__ void operator()(const pg8::f32x4 (&acc)[2][2][4][2], const pg8::Unit& u, int wr, int wc, int fr, int fq) const {
        const int row0 = u.pm * 256 + wr * 64 + fr, col0 = u.pn * 256 + wc * 32 + 4 * fq;
#pragma unroll
        for (int ai = 0; ai < 2; ++ai)
#pragma unroll
            for (int m = 0; m < 4; ++m) {
                const int row = row0 + ai * 128 + m * 16; float* xr = x + (size_t)row * DM + col0; bf16* br = xb + (size_t)row * DM + col0; float ss = 0.f;
#pragma unroll
                for (int bj = 0; bj < 2; ++bj)
#pragma unroll
                    for (int n = 0; n < 2; ++n) { const int off = bj * 128 + n * 16; const f32x4 v = *(const f32x4*)(xr + off) + acc[ai][bj][m][n];
                        *(f32x4*)(xr + off) = v; v2u w; w.x = pkbf(v[0], v[1]); w.y = pkbf(v[2], v[3]); *(v2u*)(br + off) = w; ss += dot4(v); }
                ss += __shfl_xor(ss, 16); ss += __shfl_xor(ss, 32);
                if (fq == 0) ssq[(size_t)row * 32 + u.pn * 4 + wc] = ss;
            }
    }
};

__device__ __forceinline__ void p0_item(const float* __restrict__ W, int K, int N, bf16* WT, const float* g, int mode, LAS float* scr, int item, int lane) {
    const int nblk = N >> 6, kb = item / nblk, nb = item - kb * nblk, k0 = kb << 6, n0 = nb << 6;
    f32x4 v[16];
    const float* src = W + (size_t)(k0 + (lane >> 4)) * N + n0 + 4 * (lane & 15);
#pragma unroll
    for (int i = 0; i < 16; ++i) v[i] = *(const f32x4*)(src + (size_t)(4 * i) * N);
#pragma unroll
    for (int i = 0; i < 16; ++i) { LAS float* d = scr + (4 * i + (lane >> 4)) * 65 + 4 * (lane & 15); d[0] = v[i][0]; d[1] = v[i][1]; d[2] = v[i][2]; d[3] = v[i][3]; }
    LDS_WAIT();
    const int c = lane & 7;
    f32x4 g0 = {1.f, 1.f, 1.f, 1.f}, g1 = {1.f, 1.f, 1.f, 1.f};
    if (g) { g0 = *(const f32x4*)(g + k0 + 8 * c); g1 = *(const f32x4*)(g + k0 + 8 * c + 4); }
#pragma unroll
    for (int j = 0; j < 8; ++j) {
        const int n = (lane >> 3) + 8 * j; const LAS float* s = scr + (8 * c) * 65 + n;
        v4u o; o.x = pkbf(s[0] * g0[0], s[65] * g0[1]); o.y = pkbf(s[130] * g0[2], s[195] * g0[3]); o.z = pkbf(s[260] * g1[0], s[325] * g1[1]); o.w = pkbf(s[390] * g1[2], s[455] * g1[3]);
        const int nn = n0 + n; const int row = (mode == 0) ? nn : (((nn >> 7) << 8) + (nn & 127) + (mode == 2 ? 128 : 0));
        *(v4u*)(WT + (size_t)row * K + k0 + 8 * c) = o;
    }
    LDS_WAIT();
}

struct Args {
    const float* x; const float* attn_norm; const float* w_in; const float* sinks; const float* out_norm_a; const float* out_norm_b;
    const float* w_out; const float* ffn_norm; const float* w_gate; const float* w_up; const float* w_down; const float* final_norm;
    float* out; unsigned char* ws; int ph_lo, ph_hi;
};

__device__ __forceinline__ void p0_phase(const Args& a, LAS unsigned char* lds, int wave, int lane) {
    LAS float* scr = (LAS float*)(lds + wave * 16640);
    const int gw = blockIdx.x * NWAVES + wave, NGW = gridDim.x * NWAVES;
    constexpr int I_IN = (DM / 64) * (IN_COLS / 64), I_OUT = (DM / 64) * (DM / 64), I_G = (DM / 64) * (DFF / 64), I_D = (DFF / 64) * (DM / 64);
    constexpr int I_LAYER = I_IN + I_OUT + 2 * I_G + I_D;
    for (int it = gw; it < DEPTH * I_LAYER; it += NGW) {
        const int l = it / I_LAYER; int r = it - l * I_LAYER;
        if (r < I_IN) { p0_item(a.w_in + (size_t)l * DM * IN_COLS, DM, IN_COLS, (bf16*)(a.ws + WS_WIN + l * SZ_WIN), a.attn_norm + l * DM, 0, scr, r, lane); continue; } r -= I_IN;
        if (r < I_OUT) { p0_item(a.w_out + (size_t)l * DM * DM, DM, DM, (bf16*)(a.ws + WS_WOUT + l * SZ_WOUT), nullptr, 0, scr, r, lane); continue; } r -= I_OUT;
        if (r < I_G) { p0_item(a.w_gate + (size_t)l * DM * DFF, DM, DFF, (bf16*)(a.ws + WS_WGU + l * SZ_WGU), a.ffn_norm + l * DM, 1, scr, r, lane); continue; } r -= I_G;
        if (r < I_G) { p0_item(a.w_up + (size_t)l * DM * DFF, DM, DFF, (bf16*)(a.ws + WS_WGU + l * SZ_WGU), a.ffn_norm + l * DM, 2, scr, r, lane); continue; } r -= I_G;
        p0_item(a.w_down + (size_t)l * DFF * DM, DFF, DM, (bf16*)(a.ws + WS_WDN + l * SZ_WDN), nullptr, 0, scr, r, lane);
    }
    bf16* xb = (bf16*)(a.ws + WS_XB); float* ssq = (float*)(a.ws + WS_SSQ);
    for (int m = gw; m < T; m += NGW) {
        const f32x4* xr = (const f32x4*)(a.x + (size_t)m * DM) + lane; f32x4 v[8]; float ss = 0.f;
#pragma unroll
        for (int j = 0; j < 8; ++j) { v[j] = xr[64 * j]; ss += dot4(v[j]); }
        ss = wave_sum(ss);
        f32x4* orow = (f32x4*)(a.out + (size_t)m * DM) + lane; v2u* brow = (v2u*)(xb + (size_t)m * DM) + lane;
#pragma unroll
        for (int j = 0; j < 8; ++j) { orow[64 * j] = v[j]; v2u w; w.x = pkbf(v[j][0], v[j][1]); w.y = pkbf(v[j][2], v[j][3]); brow[64 * j] = w; }
        if (lane < 32) ssq[(size_t)m * 32 + lane] = (lane == 0) ? ss : 0.f;
    }
}

constexpr int KV_PITCH = 144, KV_ROWS = 272, LDS_KOFF = 0, LDS_VOFF = KV_ROWS * KV_PITCH;
constexpr int N_UNITS_A = 3 * 1024, N_UNITS = N_UNITS_A + 1024;
__device__ __forceinline__ v4i16_t vtr(const LAS unsigned char* p) { return __builtin_amdgcn_ds_read_tr16_b64_v4i16((LAS v4i16_t*)p); }

__device__ __forceinline__ void attn_unit(LAS unsigned char* lds, const bf16* __restrict__ proj, int idx, const float* sinks_l,
                                          bf16* oA, bf16* oB, float* mA, float* lA, int tid, int wave, int lane) {
    int d, b, r, qt, qcol, kcol, vcol, br, hh; float slope, maxd, sink_l2 = 0.f;
    if (idx < N_UNITS_A) {
        br = idx >> 10; const int rem = idx & 1023; d = (br == 0) ? 1 : (br == 1 ? 4 : 16);
        b = rem >> 8; hh = (rem >> 4) & 15; const int nqt = 16 / d, w16 = rem & 15; r = w16 / nqt; qt = w16 - r * nqt;
        qcol = C_QA + hh * 64; kcol = C_KA + hh * 64; vcol = C_VA + hh * 64;
        slope = __builtin_amdgcn_exp2f(-(float)(2 * hh + 1) * 0.25f); maxd = 128.f;
    } else {
        br = 3; const int rem = idx - N_UNITS_A; d = 1; r = 0;
        b = rem >> 8; const int g = (rem >> 7) & 1, rr = (rem >> 4) & 7; qt = rem & 15; hh = g * 8 + rr;
        qcol = C_QB + hh * 64; kcol = C_KB + g * 64; vcol = C_VB + g * 64;
        slope = __builtin_amdgcn_exp2f(-(float)(hh + 1) * 0.5f); maxd = 127.f;
        sink_l2 = sinks_l[hh] * LOG2E;
    }
    const float sl2 = slope * (float)d * LOG2E;
    const float C2 = 0.125f * LOG2E;
    const int fr = lane & 15, fq = lane >> 4;
    {
        const int c8 = tid & 7, r0 = tid >> 3;
#pragma unroll
        for (int i = 0; i < 4; ++i) {
            const int row = r0 + 64 * i, ks = 128 * qt - 128 + row;
            v4u kv = {0u, 0u, 0u, 0u}, vv = {0u, 0u, 0u, 0u};
            if (ks >= 0) { const bf16* p = proj + (size_t)(b * SEQ + r + d * ks) * IN_COLS + 8 * c8; kv = *(const v4u*)(p + kcol); vv = *(const v4u*)(p + vcol); }
            *(LAS v4u*)(lds + LDS_KOFF + row * KV_PITCH + 16 * c8) = kv;
            *(LAS v4u*)(lds + LDS_VOFF + row * KV_PITCH + 16 * c8) = vv;
        }
        if (tid < 128) { const int row = 256 + (tid >> 3); const v4u z = {0u, 0u, 0u, 0u};
            *(LAS v4u*)(lds + LDS_KOFF + row * KV_PITCH + 16 * c8) = z; *(LAS v4u*)(lds + LDS_VOFF + row * KV_PITCH + 16 * c8) = z; }
    }
    const int iq = 128 * qt + 16 * wave + fr;
    const size_t grow = (size_t)(b * SEQ + r + d * iq);
    const bf16* qp = proj + grow * IN_COLS + qcol + 8 * fq;
    const bf16x8 q0 = *(const bf16x8*)qp, q1 = *(const bf16x8*)(qp + 32);
    __syncthreads();
    f32x4 sc[9];
    {
        const LAS unsigned char* kb = lds + LDS_KOFF + (16 * wave + fr) * KV_PITCH + 16 * fq;
#pragma unroll
        for (int j = 0; j < 9; ++j) {
            const bf16x8 k0 = *(const LAS bf16x8*)(kb + j * 16 * KV_PITCH), k1 = *(const LAS bf16x8*)(kb + j * 16 * KV_PITCH + 64);
            f32x4 z = {0.f, 0.f, 0.f, 0.f};
            z = __builtin_amdgcn_mfma_f32_16x16x32_bf16(k0, q0, z, 0, 0, 0);
            sc[j] = __builtin_amdgcn_mfma_f32_16x16x32_bf16(k1, q1, z, 0, 0, 0);
        }
    }
    const float bl = (float)(fr - 4 * fq);
    const bool early = (qt == 0);
    float mx = -INFINITY;
#pragma unroll
    for (int j = 0; j < 9; ++j)
#pragma unroll
        for (int jj = 0; jj < 4; ++jj) {
            const float dist = (float)(128 - 16 * j - jj) + bl;
            float v = __builtin_fmaf(sc[j][jj], C2, -sl2 * dist);
            bool ok = true;
            if (j == 0) ok = dist <= maxd;
            if (j == 8) ok = dist >= 0.f;
            if (early && (wave + j < 8)) ok = false;
            v = ok ? v : -INFINITY; sc[j][jj] = v; mx = __builtin_fmaxf(mx, v);
        }
    mx = __builtin_fmaxf(mx, __shfl_xor(mx, 16)); mx = __builtin_fmaxf(mx, __shfl_xor(mx, 32));
    float lsum = 0.f;
#pragma unroll
    for (int j = 0; j < 9; ++j)
#pragma unroll
        for (int jj = 0; jj < 4; ++jj) { const float p = __builtin_amdgcn_exp2f(sc[j][jj] - mx); sc[j][jj] = p; lsum += p; }
    lsum += __shfl_xor(lsum, 16); lsum += __shfl_xor(lsum, 32);
    f32x4 o[4];
#pragma unroll
    for (int dt = 0; dt < 4; ++dt) o[dt] = (f32x4){0.f, 0.f, 0.f, 0.f};
    {
        const int q4 = (lane & 15) >> 2, p4 = lane & 3;
        const LAS unsigned char* vb = lds + LDS_VOFF + (16 * wave + 4 * fq + q4) * KV_PITCH + 8 * p4;
#pragma unroll
        for (int c = 0; c < 5; ++c) {
            v4u yw; yw.x = pkbf(sc[2 * c][0], sc[2 * c][1]); yw.y = pkbf(sc[2 * c][2], sc[2 * c][3]);
            if (c < 4) { yw.z = pkbf(sc[(c < 4) ? 2 * c + 1 : 0][0], sc[(c < 4) ? 2 * c + 1 : 0][1]); yw.w = pkbf(sc[(c < 4) ? 2 * c + 1 : 0][2], sc[(c < 4) ? 2 * c + 1 : 0][3]); }
            else { yw.z = 0u; yw.w = 0u; }
            const bf16x8 Y = __builtin_bit_cast(bf16x8, yw);
#pragma unroll
            for (int dt = 0; dt < 4; ++dt) {
                const v4i16_t lo = vtr(vb + (32 * c) * KV_PITCH + 32 * dt), hi = vtr(vb + (32 * c + 16) * KV_PITCH + 32 * dt);
                const bf16x8 X = {lo[0], lo[1], lo[2], lo[3], hi[0], hi[1], hi[2], hi[3]};
                o[dt] = __builtin_amdgcn_mfma_f32_16x16x32_bf16(X, Y, o[dt], 0, 0, 0);
            }
        }
    }
    float inv; bf16* op;
    if (br < 3) {
        inv = __builtin_amdgcn_rcpf(lsum);
        if (fq == 0) { mA[((size_t)br * T + grow) * 16 + hh] = mx; lA[((size_t)br * T + grow) * 16 + hh] = lsum; }
        op = oA + ((size_t)br * T + grow) * 1024 + hh * 64 + 4 * fq;
    } else {
        const float m2 = __builtin_fmaxf(mx, sink_l2), cf = __builtin_amdgcn_exp2f(mx - m2);
        inv = cf * __builtin_amdgcn_rcpf(lsum * cf + __builtin_amdgcn_exp2f(sink_l2 - m2));
        op = oB + grow * 1024 + hh * 64 + 4 * fq;
    }
#pragma unroll
    for (int dt = 0; dt < 4; ++dt) { v2u w; w.x = pkbf(o[dt][0] * inv, o[dt][1] * inv); w.y = pkbf(o[dt][2] * inv, o[dt][3] * inv); *(v2u*)(op + 16 * dt) = w; }
    __syncthreads();
}

__device__ __forceinline__ void merge_phase(const Args& a, int layer, int wave, int lane) {
    const bf16* oA = (const bf16*)(a.ws + WS_OA); const bf16* oB = (const bf16*)(a.ws + WS_OB);
    const float* mA = (const float*)(a.ws + WS_MA); const float* lA = (const float*)(a.ws + WS_LA);
    bf16* mix = (bf16*)(a.ws + WS_MIX);
    const float* gA = a.out_norm_a + layer * 1024 + lane * 16; const float* gB = a.out_norm_b + layer * 1024 + lane * 16;
    const int gw = blockIdx.x * NWAVES + wave, NGW = gridDim.x * NWAVES, ha = lane >> 2;
    for (int t = gw; t < T; t += NGW) {
        float wgt[3]; float mxx = -INFINITY;
#pragma unroll
        for (int i = 0; i < 3; ++i) { wgt[i] = mA[((size_t)i * T + t) * 16 + ha]; mxx = __builtin_fmaxf(mxx, wgt[i]); }
        float wsum = 0.f;
#pragma unroll
        for (int i = 0; i < 3; ++i) { wgt[i] = __builtin_amdgcn_exp2f(wgt[i] - mxx) * lA[((size_t)i * T + t) * 16 + ha]; wsum += wgt[i]; }
        const float winv = 1.0f / wsum;
        float acc[16];
#pragma unroll
        for (int k = 0; k < 16; ++k) acc[k] = 0.f;
#pragma unroll
        for (int i = 0; i < 3; ++i) {
            const v4u* p = (const v4u*)(oA + ((size_t)i * T + t) * 1024 + lane * 16); const float wi = wgt[i] * winv;
#pragma unroll
            for (int h2 = 0; h2 < 2; ++h2) { const v4u q = p[h2];
#pragma unroll
                for (int k = 0; k < 4; ++k) { acc[h2 * 8 + 2 * k] += wi * __uint_as_float(q[k] << 16); acc[h2 * 8 + 2 * k + 1] += wi * __uint_as_float(q[k] & 0xffff0000u); } }
        }
        float ss = 0.f;
#pragma unroll
        for (int k = 0; k < 16; ++k) ss += acc[k] * acc[k];
        ss = wave_sum(ss);
        float rs = __builtin_amdgcn_rsqf(ss * (1.0f / 1024.f) + EPS);
        {
            v4u o0, o1; const f32x4 g0 = *(const f32x4*)(gA), g1 = *(const f32x4*)(gA + 4), g2 = *(const f32x4*)(gA + 8), g3 = *(const f32x4*)(gA + 12);
            o0.x = pkbf(acc[0] * rs * g0[0], acc[1] * rs * g0[1]); o0.y = pkbf(acc[2] * rs * g0[2], acc[3] * rs * g0[3]);
            o0.z = pkbf(acc[4] * rs * g1[0], acc[5] * rs * g1[1]); o0.w = pkbf(acc[6] * rs * g1[2], acc[7] * rs * g1[3]);
            o1.x = pkbf(acc[8] * rs * g2[0], acc[9] * rs * g2[1]); o1.y = pkbf(acc[10] * rs * g2[2], acc[11] * rs * g2[3]);
            o1.z = pkbf(acc[12] * rs * g3[0], acc[13] * rs * g3[1]); o1.w = pkbf(acc[14] * rs * g3[2], acc[15] * rs * g3[3]);
            v4u* mp = (v4u*)(mix + (size_t)t * DM + lane * 16); mp[0] = o0; mp[1] = o1;
        }
        {
            const v4u* p = (const v4u*)(oB + (size_t)t * 1024 + lane * 16);
#pragma unroll
            for (int h2 = 0; h2 < 2; ++h2) { const v4u q = p[h2];
#pragma unroll
                for (int k = 0; k < 4; ++k) { acc[h2 * 8 + 2 * k] = __uint_as_float(q[k] << 16); acc[h2 * 8 + 2 * k + 1] = __uint_as_float(q[k] & 0xffff0000u); } }
            ss = 0.f;
#pragma unroll
            for (int k = 0; k < 16; ++k) ss += acc[k] * acc[k];
            ss = wave_sum(ss);
            rs = __builtin_amdgcn_rsqf(ss * (1.0f / 1024.f) + EPS);
            v4u o0, o1; const f32x4 g0 = *(const f32x4*)(gB), g1 = *(const f32x4*)(gB + 4), g2 = *(const f32x4*)(gB + 8), g3 = *(const f32x4*)(gB + 12);
            o0.x = pkbf(acc[0] * rs * g0[0], acc[1] * rs * g0[1]); o0.y = pkbf(acc[2] * rs * g0[2], acc[3] * rs * g0[3]);
            o0.z = pkbf(acc[4] * rs * g1[0], acc[5] * rs * g1[1]); o0.w = pkbf(acc[6] * rs * g1[2], acc[7] * rs * g1[3]);
            o1.x = pkbf(acc[8] * rs * g2[0], acc[9] * rs * g2[1]); o1.y = pkbf(acc[10] * rs * g2[2], acc[11] * rs * g2[3]);
            o1.z = pkbf(acc[12] * rs * g3[0], acc[13] * rs * g3[1]); o1.w = pkbf(acc[14] * rs * g3[2], acc[15] * rs * g3[3]);
            v4u* mp = (v4u*)(mix + (size_t)t * DM + 1024 + lane * 16); mp[0] = o0; mp[1] = o1;
        }
    }
}

__device__ __forceinline__ void final_phase(const Args& a, int wave, int lane) {
    const int gw = blockIdx.x * NWAVES + wave, NGW = gridDim.x * NWAVES;
    for (int m = gw; m < T; m += NGW) {
        f32x4* xr = (f32x4*)(a.out + (size_t)m * DM) + lane; const f32x4* gr = (const f32x4*)a.final_norm + lane; f32x4 v[8]; float ss = 0.f;
#pragma unroll
        for (int j = 0; j < 8; ++j) { v[j] = xr[64 * j]; ss += dot4(v[j]); }
        ss = wave_sum(ss);
        const float rs = __builtin_amdgcn_rsqf(ss * (1.0f / DM) + EPS);
#pragma unroll
        for (int j = 0; j < 8; ++j) xr[64 * j] = v[j] * rs * gr[64 * j];
    }
}

constexpr int N_PHASES = 2 + 6 * DEPTH;
__global__ void __launch_bounds__(NTHREADS, 2) fwd_megakernel(Args a) {
    extern __shared__ __attribute__((aligned(16))) unsigned char lds_raw[];
    cg::grid_group grid = cg::this_grid();
    LAS unsigned char* lds = (LAS unsigned char*)lds_raw;
    bf16* xb = (bf16*)(a.ws + WS_XB); bf16* proj = (bf16*)(a.ws + WS_PROJ); bf16* mix = (bf16*)(a.ws + WS_MIX); bf16* act = (bf16*)(a.ws + WS_ACT);
    float* ssq = (float*)(a.ws + WS_SSQ);
    for (int ph = a.ph_lo; ph < a.ph_hi; ++ph) {
        int tid_l = threadIdx.x; asm volatile("" : "+v"(tid_l));
        const int tid = tid_l, lane = tid & 63, wave = __builtin_amdgcn_readfirstlane(tid >> 6);
        if (ph == 0) p0_phase(a, lds, wave, lane);
        else if (ph == N_PHASES - 1) final_phase(a, wave, lane);
        else {
            const int l = (ph - 1) / 6, k = (ph - 1) - 6 * l;
            if (k == 0) {
                pg8::Gemm g{xb, (const bf16*)(a.ws + WS_WIN + l * SZ_WIN), T, IN_COLS, DM}; pg8::StaticOrder S; S.init(T, IN_COLS, (int)gridDim.x, (int)blockIdx.x);
                EpiScaleBf16 E{proj, IN_COLS, ssq};
                pg8::gemm_phase<EpiScaleBf16, pg8::StaticOrder, true, true>(lds, g, S, E);
            } else if (k == 1) {
                for (int idx = blockIdx.x; idx < N_UNITS; idx += gridDim.x)
                    attn_unit(lds, proj, idx, a.sinks + l * 16, (bf16*)(a.ws + WS_OA), (bf16*)(a.ws + WS_OB), (float*)(a.ws + WS_MA), (float*)(a.ws + WS_LA), tid, wave, lane);
            } else if (k == 2) {
                merge_phase(a, l, wave, lane);
            } else if (k == 3) {
                pg8::Gemm g{mix, (const bf16*)(a.ws + WS_WOUT + l * SZ_WOUT), T, DM, DM}; pg8::StaticOrder S; S.init(T, DM, (int)gridDim.x, (int)blockIdx.x);
                EpiResid E{a.out, xb, ssq};
                pg8::gemm_phase<EpiResid, pg8::StaticOrder, false, true>(lds, g, S, E);
            } else if (k == 4) {
                pg8::Gemm g{xb, (const bf16*)(a.ws + WS_WGU + l * SZ_WGU), T, NGU, DM}; pg8::StaticOrder S; S.init(T, NGU, (int)gridDim.x, (int)blockIdx.x);
                EpiSwiglu E{act, ssq};
                pg8::gemm_phase<EpiSwiglu, pg8::StaticOrder, true, true>(lds, g, S, E);
            } else {
                pg8::Gemm g{act, (const bf16*)(a.ws + WS_WDN + l * SZ_WDN), T, DM, DFF}; pg8::StaticOrder S; S.init(T, DM, (int)gridDim.x, (int)blockIdx.x);
                EpiResid E{a.out, xb, ssq};
                pg8::gemm_phase<EpiResid, pg8::StaticOrder, false, true>(lds, g, S, E);
            }
        }
        if (ph + 1 < a.ph_hi) grid.sync();
    }
}

extern "C" void kernel_launch(void* const* d_in, const int* in_sizes, int n_in, void* d_out, int out_size, void* d_ws, size_t ws_size, hipStream_t stream) {
    static int grid = 0;
    if (grid == 0) {
        if (n_in != 12 || in_sizes[0] != T * DM || out_size != T * DM || ws_size < WS_END) { fprintf(stderr, "kernel_launch: unexpected shapes (n_in %d, out %d, ws %zu < %zu)\n", n_in, out_size, ws_size, (size_t)WS_END); grid = -1; return; }
        int dev = 0, cus = 0, per_cu = 0;
        if (hipGetDevice(&dev) != hipSuccess || hipDeviceGetAttribute(&cus, hipDeviceAttributeMultiprocessorCount, dev) != hipSuccess) { grid = -1; return; }
        if (hipFuncSetAttribute((const void*)fwd_megakernel, hipFuncAttributeMaxDynamicSharedMemorySize, LDS_BYTES) != hipSuccess) { fprintf(stderr, "kernel_launch: hipFuncSetAttribute failed\n"); grid = -1; return; }
        if (hipOccupancyMaxActiveBlocksPerMultiprocessor(&per_cu, (const void*)fwd_megakernel, NTHREADS, LDS_BYTES) != hipSuccess || per_cu < 1) per_cu = 1;
        (void)hipGetLastError();
        grid = cus * per_cu;
    }
    if (grid < 0) return;
    Args a{};
    a.x = (const float*)d_in[0]; a.attn_norm = (const float*)d_in[1]; a.w_in = (const float*)d_in[2]; a.sinks = (const float*)d_in[3];
    a.out_norm_a = (const float*)d_in[4]; a.out_norm_b = (const float*)d_in[5]; a.w_out = (const float*)d_in[6]; a.ffn_norm = (const float*)d_in[7];
    a.w_gate = (const float*)d_in[8]; a.w_up = (const float*)d_in[9]; a.w_down = (const float*)d_in[10]; a.final_norm = (const float*)d_in[11];
    a.out = (float*)d_out; a.ws = (unsigned char*)d_ws; a.ph_lo = 0; a.ph_hi = N_PHASES;
    void* args[] = {&a};
    const hipError_t e = hipLaunchCooperativeKernel((const void*)fwd_megakernel, dim3(grid), dim3(NTHREADS), args, LDS_BYTES, stream);
    if (e != hipSuccess) fprintf(stderr, "kernel_launch: cooperative launch failed: %s (grid %d)\n", hipGetErrorString(e), grid);
}
```

```cpp
#include <hip/hip_runtime.h>
#include <hip/hip_cooperative_groups.h>
#include <cstdio>
#include <cstdint>
namespace cg = cooperative_groups;
namespace pg8 {
#define PG8_LAS __attribute__((address_space(3)))
typedef unsigned short bf16_t;
typedef short bf16x8 __attribute__((ext_vector_type(8)));
typedef float f32x4 __attribute__((ext_vector_type(4)));
typedef unsigned u32x4 __attribute__((ext_vector_type(4)));
constexpr int BM = 256, BK = 64, HALF = 128, HTB = HALF * BK * 2  , STAGE_BYTES = 8 * HTB, NXCD = 8, WGM = 8;

__host__ __device__ __forceinline__ int lds_byte(int r, int c) { const int st = (r >> 4) * 2 + (c >> 5), rr = r & 15, cc = c & 31, ob = rr * 64 + cc * 2; return st * 1024 + (ob ^ (((ob >> 9) & 1) << 5)); }
__host__ __device__ __forceinline__ void stage_rc(int b, int& R, int& C) { const int st = b / 1024, sb = b % 1024, swz = sb ^ (((sb >> 9) & 1) << 5); R = (st >> 1) * 16 + swz / 64; C = (st & 1) * 32 + (swz % 64) / 2; }
__host__ __device__ __forceinline__ int perm32(int rho) { const int n = rho >> 4, i = rho & 15; return 8 * (i >> 2) + 4 * n + (i & 3); }

struct Unit { int pm, pn; };
struct Gemm { const bf16_t* A; const bf16_t* Bt; int M, N, K; };

struct StaticOrder {
    int nM, nN, nwg, G, c;
    __host__ __device__ void init(int M, int N, int G_, int c_) { nM = M / BM; nN = N / BM; nwg = nM * nN; G = G_; c = c_; }
    __host__ __device__ bool next(int i, Unit& u) const {
        const long L = (long)i * G + c; if (L >= nwg) return false;
        int wgid = (int)L; { const int q = nwg / NXCD, r = nwg % NXCD, xcd = wgid % NXCD, off = wgid / NXCD; wgid = (xcd < r ? xcd * (q + 1) : r * (q + 1) + (xcd - r) * q) + off; }
        const int nig = WGM * nN, gid = wgid / nig, fm = gid * WGM, gsz = (nM - fm) < WGM ? (nM - fm) : WGM;
        u.pm = fm + ((wgid % nig) % gsz); u.pn = (wgid % nig) / gsz; return true;
    }
    __device__ __forceinline__ void a_ready(const Unit&) const {}
    __device__ __forceinline__ void done(const Unit&) const {}
};

__device__ __forceinline__ unsigned cvt_pk_bf16(float lo, float hi) { unsigned r; asm volatile("v_cvt_pk_bf16_f32 %0, %1, %2" : "=v"(r) : "v"(lo), "v"(hi)); return r; }
typedef float f32x2 __attribute__((ext_vector_type(2)));
template <class Epi, class Sched, bool ALIGN_EPI = false, bool SP2 = false>
__device__ __forceinline__ void gemm_phase(PG8_LAS unsigned char* lds, const Gemm g, const Sched& S, const Epi& E) {
    int tid_l = threadIdx.x; asm volatile("" : "+v"(tid_l));
    const int tid = tid_l, wid = __builtin_amdgcn_readfirstlane(tid >> 6), lane = tid & 63, wr = wid >> 2, wc = wid & 3, fr = lane & 15, fq = lane >> 4;
    const int K = g.K, nt = K / BK;
    unsigned voffA[2], voffB[2];
#pragma unroll
    for (int i = 0; i < 2; ++i) { int R, C; stage_rc(tid * 16 + i * 8192, R, C); const int Rb = Epi::PERM ? ((R & ~31) + perm32(R & 31)) : R;
        voffA[i] = (unsigned)(R * K + C) * 2u; voffB[i] = (unsigned)(Rb * K + C) * 2u; }
    const size_t kstep = (size_t)(BK * 2);
    const size_t hstep = (size_t)HALF * K * 2;
    const size_t tstep = 2 * hstep;
    const unsigned ldsw = (unsigned)wid * 1024u;
    const int aoff = lds_byte(wr * 64 + fr, fq * 8), boff = lds_byte(wc * 32 + fr, fq * 8);
#define PG8_SA(b, h) (((b) * 2 + (h)) * HTB)
#define PG8_SB(b, h) ((4 + (b) * 2 + (h)) * HTB)
#define PG8_STAGE(bufoff, gbase, voff) do { _Pragma("unroll") for (int _i = 0; _i < 2; ++_i) \
        __builtin_amdgcn_global_load_lds((const unsigned*)((const char*)(gbase) + (voff)[_i]), (PG8_LAS unsigned*)(lds + (bufoff) + ldsw + _i * 8192), 16, 0, 0); } while (0)
#define PG8_LDA(dst, b, h) do { _Pragma("unroll") for (int m = 0; m < 4; ++m) _Pragma("unroll") for (int k = 0; k < 2; ++k) dst[m][k] = *(const PG8_LAS bf16x8*)(lds + PG8_SA(b, h) + aoff + m * 2048 + k * 1024); } while (0)
#define PG8_LDB(dst, b, h) do { _Pragma("unroll") for (int n = 0; n < 2; ++n) _Pragma("unroll") for (int k = 0; k < 2; ++k) dst[n][k] = *(const PG8_LAS bf16x8*)(lds + PG8_SB(b, h) + boff + n * 2048 + k * 1024); } while (0)
#define PG8_MMA(ai, bj, At, Bt) do { __builtin_amdgcn_s_setprio(1); _Pragma("unroll") for (int m = 0; m < 4; ++m) _Pragma("unroll") for (int n = 0; n < 2; ++n) _Pragma("unroll") for (int k = 0; k < 2; ++k) \
        acc[ai][bj][m][n] = __builtin_amdgcn_mfma_f32_16x16x32_bf16(Bt[n][k], At[m][k], acc[ai][bj][m][n], 0, 0, 0); __builtin_amdgcn_s_setprio(0); } while (0)
#define PG8_WAIT_V(n) asm volatile("s_waitcnt vmcnt(" #n ")" ::: "memory")
#define PG8_WAIT_L(n) asm volatile("s_waitcnt lgkmcnt(" #n ")" ::: "memory")
#define PG8_BAR __builtin_amdgcn_s_barrier()
#define PG8_SCHED __builtin_amdgcn_sched_barrier(0)
    Unit cur, nxt; int ui = 0;
    if (!S.next(0, cur)) return;
    f32x4 acc[2][2][4][2];
#pragma unroll
    for (int a = 0; a < 2; ++a)
#pragma unroll
        for (int b = 0; b < 2; ++b)
#pragma unroll
            for (int m = 0; m < 4; ++m)
#pragma unroll
                for (int n = 0; n < 2; ++n) acc[a][b][m][n] = (f32x4){0.f, 0.f, 0.f, 0.f};
    bf16x8 At[4][2], B0[2][2], B1[2][2];
    const char* cA = (const char*)g.A + (size_t)cur.pm * tstep; const char* cB = (const char*)g.Bt + (size_t)cur.pn * tstep;
    S.a_ready(cur);
    if constexpr (SP2) {
        PG8_STAGE(PG8_SB(0, 0), cB, voffB); PG8_STAGE(PG8_SB(0, 1), cB + hstep, voffB); PG8_STAGE(PG8_SA(0, 0), cA, voffA); PG8_STAGE(PG8_SA(0, 1), cA + hstep, voffA);
        if (wr == 1) PG8_BAR;
        PG8_WAIT_V(2); PG8_BAR;
        PG8_STAGE(PG8_SB(1, 0), cB + kstep, voffB); PG8_STAGE(PG8_SA(1, 0), cA + kstep, voffA); PG8_STAGE(PG8_SB(1, 1), cB + hstep + kstep, voffB);
        PG8_WAIT_V(6); PG8_BAR;
    } else {
        PG8_STAGE(PG8_SB(0, 0), cB, voffB); PG8_STAGE(PG8_SA(0, 0), cA, voffA); PG8_STAGE(PG8_SB(0, 1), cB + hstep, voffB); PG8_STAGE(PG8_SA(0, 1), cA + hstep, voffA);
        if (wr == 1) PG8_BAR;
        PG8_WAIT_V(4); PG8_BAR;
        PG8_STAGE(PG8_SB(1, 0), cB + kstep, voffB); PG8_STAGE(PG8_SA(1, 0), cA + kstep, voffA); PG8_STAGE(PG8_SB(1, 1), cB + hstep + kstep, voffB);
        PG8_WAIT_V(6); PG8_BAR;
    }
    for (;;) {
        const bool has_next = S.next(ui + 1, nxt);
        const char* nA = has_next ? (const char*)g.A + (size_t)nxt.pm * tstep : cA; const char* nB = has_next ? (const char*)g.Bt + (size_t)nxt.pn * tstep : cB;
        for (int t = 0; t < nt; t += 2) {
            const bool last = (t == nt - 2);
            const char* a1 = cA + (size_t)(t + 1) * kstep;
            const char* a2 = last ? nA : cA + (size_t)(t + 2) * kstep; const char* b2 = last ? nB : cB + (size_t)(t + 2) * kstep;
            const char* a3 = a2 + kstep; const char* b3 = b2 + kstep;
            if (last && has_next) S.a_ready(nxt);
            if constexpr (SP2) {
            PG8_LDB(B0, 0, 0); PG8_LDB(B1, 0, 1); PG8_SCHED; PG8_LDA(At, 0, 0); PG8_STAGE(PG8_SA(1, 1), a1 + hstep, voffA);
            PG8_WAIT_V(8); PG8_WAIT_L(0); PG8_BAR; PG8_MMA(0, 0, At, B0); PG8_MMA(0, 1, At, B1); PG8_BAR; PG8_SCHED;
            PG8_LDA(At, 0, 1); PG8_STAGE(PG8_SB(0, 0), b2, voffB); PG8_STAGE(PG8_SB(0, 1), b2 + hstep, voffB); PG8_STAGE(PG8_SA(0, 0), a2, voffA);
            PG8_WAIT_V(8); PG8_WAIT_L(0); PG8_BAR; PG8_MMA(1, 0, At, B0); PG8_MMA(1, 1, At, B1); PG8_BAR; PG8_SCHED;
            PG8_LDB(B0, 1, 0); PG8_LDB(B1, 1, 1); PG8_SCHED; PG8_LDA(At, 1, 0); PG8_STAGE(PG8_SA(0, 1), a2 + hstep, voffA);
            PG8_WAIT_V(8); PG8_WAIT_L(0); PG8_BAR; PG8_MMA(0, 0, At, B0); PG8_MMA(0, 1, At, B1); PG8_BAR; PG8_SCHED;
            PG8_LDA(At, 1, 1); PG8_STAGE(PG8_SB(1, 0), b3, voffB); PG8_STAGE(PG8_SB(1, 1), b3 + hstep, voffB); PG8_STAGE(PG8_SA(1, 0), a3, voffA);
            PG8_WAIT_V(8); PG8_WAIT_L(0); PG8_BAR; PG8_MMA(1, 0, At, B0); PG8_MMA(1, 1, At, B1); PG8_BAR; PG8_SCHED;
            } else {
            PG8_LDB(B0, 0, 0); PG8_SCHED; PG8_LDA(At, 0, 0); PG8_STAGE(PG8_SA(1, 1), a1 + hstep, voffA);
            PG8_WAIT_L(8); PG8_BAR; PG8_WAIT_L(0); PG8_MMA(0, 0, At, B0); PG8_BAR; PG8_SCHED;
            PG8_LDB(B1, 0, 1); PG8_STAGE(PG8_SB(0, 0), b2, voffB);
            PG8_BAR; PG8_WAIT_L(0); PG8_MMA(0, 1, At, B1); PG8_BAR;
            PG8_LDA(At, 0, 1); PG8_STAGE(PG8_SA(0, 0), a2, voffA);
            PG8_BAR; PG8_WAIT_L(0); PG8_MMA(1, 0, At, B0); PG8_BAR; PG8_SCHED;
            PG8_STAGE(PG8_SB(0, 1), b2 + hstep, voffB);
            PG8_WAIT_V(6); PG8_BAR; PG8_MMA(1, 1, At, B1); PG8_BAR;
            PG8_LDB(B0, 1, 0); PG8_SCHED; PG8_LDA(At, 1, 0); PG8_STAGE(PG8_SA(0, 1), a2 + hstep, voffA);
            PG8_WAIT_L(8); PG8_BAR; PG8_WAIT_L(0); PG8_MMA(0, 0, At, B0); PG8_BAR; PG8_SCHED;
            PG8_LDB(B1, 1, 1); PG8_STAGE(PG8_SB(1, 0), b3, voffB);
            PG8_BAR; PG8_WAIT_L(0); PG8_MMA(0, 1, At, B1); PG8_BAR;
            PG8_LDA(At, 1, 1); PG8_STAGE(PG8_SA(1, 0), a3, voffA);
            PG8_BAR; PG8_WAIT_L(0); PG8_MMA(1, 0, At, B0); PG8_BAR; PG8_SCHED;
            PG8_STAGE(PG8_SB(1, 1), b3 + hstep, voffB);
            PG8_WAIT_V(6); PG8_BAR; PG8_MMA(1, 1, At, B1); PG8_BAR;
            }
        }
        if constexpr (ALIGN_EPI) { if (wr == 0) PG8_BAR; }
        if constexpr (!Epi::AFTER_DRAIN) { E(acc, cur, wr, wc, fr, fq); S.done(cur); }
        if (!has_next) break;
#pragma unroll
        for (int a = 0; a < 2; ++a)
#pragma unroll
            for (int b = 0; b < 2; ++b)
#pragma unroll
                for (int m = 0; m < 4; ++m)
#pragma unroll
                    for (int n = 0; n < 2; ++n) acc[a][b][m][n] = (f32x4){0.f, 0.f, 0.f, 0.f};
        cur = nxt; cA = nA; cB = nB; ++ui;
        if constexpr (ALIGN_EPI) { if (wr == 1) PG8_BAR; }
    }
    PG8_WAIT_V(0);
    if constexpr (!ALIGN_EPI) { if (wr == 0) PG8_BAR; }
    PG8_BAR;
    if constexpr (Epi::AFTER_DRAIN) { E.fused(acc, cur, wr, wc, fr, fq, lds, wid, lane); S.done(cur); }
#undef PG8_SA
#undef PG8_SB
#undef PG8_STAGE
#undef PG8_LDA
#undef PG8_LDB
#undef PG8_MMA
#undef PG8_WAIT_V
#undef PG8_WAIT_L
#undef PG8_BAR
#undef PG8_SCHED
}
}

#define LAS __attribute__((address_space(3)))
typedef unsigned short bf16;
typedef unsigned v4u __attribute__((ext_vector_type(4)));
typedef unsigned v2u __attribute__((ext_vector_type(2)));
typedef float f32x4 __attribute__((ext_vector_type(4)));
typedef short bf16x8 __attribute__((ext_vector_type(8)));
typedef short v4i16_t __attribute__((ext_vector_type(4)));

constexpr int BATCH = 4, SEQ = 2048, DM = 2048, DEPTH = 4;
constexpr int T = BATCH * SEQ;
constexpr int IN_COLS = 4352, DFF = 5632, NGU = 2 * DFF;
constexpr int C_QA = 0, C_KA = 1024, C_VA = 2048, C_QB = 3072, C_KB = 4096, C_VB = 4224;
constexpr float EPS = 1e-6f, LOG2E = 1.4426950408889634f;
constexpr int NWAVES = 8, NTHREADS = 512;
constexpr int LDS_BYTES = 136 * 1024;

constexpr size_t SZ_WIN = (size_t)IN_COLS * DM * 2, SZ_WOUT = (size_t)DM * DM * 2, SZ_WGU = (size_t)NGU * DM * 2, SZ_WDN = (size_t)DM * DFF * 2;
constexpr size_t WS_WIN = 0;
constexpr size_t WS_WOUT = WS_WIN + DEPTH * SZ_WIN;
constexpr size_t WS_WGU = WS_WOUT + DEPTH * SZ_WOUT;
constexpr size_t WS_WDN = WS_WGU + DEPTH * SZ_WGU;
constexpr size_t WS_XB = WS_WDN + DEPTH * SZ_WDN;
constexpr size_t WS_PROJ = WS_XB + (size_t)T * DM * 2;
constexpr size_t WS_OA = WS_PROJ + (size_t)T * IN_COLS * 2;
constexpr size_t WS_OB = WS_OA + 3 * (size_t)T * 1024 * 2;
constexpr size_t WS_MIX = WS_OB + (size_t)T * 1024 * 2;
constexpr size_t WS_ACT = WS_MIX + (size_t)T * DM * 2;
constexpr size_t WS_SSQ = WS_ACT + (size_t)T * DFF * 2;
constexpr size_t WS_MA = WS_SSQ + (size_t)T * 32 * 4;
constexpr size_t WS_LA = WS_MA + 3 * (size_t)T * 16 * 4;
constexpr size_t WS_BAR = WS_LA + 3 * (size_t)T * 16 * 4;
constexpr size_t BAR_BYTES = 16384;
constexpr size_t WS_END = WS_BAR + BAR_BYTES;
constexpr int MISC_OFF = 135168;

#define LDS_WAIT() asm volatile("s_waitcnt lgkmcnt(0)" ::: "memory")
__device__ __forceinline__ unsigned pkbf(float lo, float hi) { return pg8::cvt_pk_bf16(lo, hi); }
__device__ __forceinline__ float wave_sum(float v) {
#pragma unroll
    for (int o = 1; o < 64; o <<= 1) v += __shfl_xor(v, o);
    return v;
}
__device__ __forceinline__ float dot4(f32x4 v) { return (v[0] * v[0] + v[1] * v[1]) + (v[2] * v[2] + v[3] * v[3]); }

__device__ __forceinline__ float row_rstd(const float* ssq, int row, int fq) {
    const f32x4 a = *(const f32x4*)(ssq + (size_t)row * 32 + 8 * fq), b = *(const f32x4*)(ssq + (size_t)row * 32 + 8 * fq + 4);
    float s = ((a[0] + a[1]) + (a[2] + a[3])) + ((b[0] + b[1]) + (b[2] + b[3]));
    s += __shfl_xor(s, 16); s += __shfl_xor(s, 32);
    return __builtin_amdgcn_rsqf(s * (1.0f / DM) + EPS);
}
struct EpiScaleBf16 {
    static constexpr bool PERM = true, AFTER_DRAIN = false;
    bf16* O; int ldc; const float* ssq;
    __device__ __forceinline__ void operator()(const pg8::f32x4 (&acc)[2][2][4][2], const pg8::Unit& u, int wr, int wc, int fr, int fq) const {
        const int row0 = u.pm * 256 + wr * 64 + fr, col0 = u.pn * 256 + wc * 32 + 8 * fq;
#pragma unroll
        for (int ai = 0; ai < 2; ++ai)
#pragma unroll
            for (int m = 0; m < 4; ++m) {
                const int row = row0 + ai * 128 + m * 16; const float rs = row_rstd(ssq, row, fq); bf16* rowp = O + (size_t)row * ldc + col0;
#pragma unroll
                for (int bj = 0; bj < 2; ++bj) { const f32x4 v0 = acc[ai][bj][m][0] * rs, v1 = acc[ai][bj][m][1] * rs;
                    v4u w; w.x = pkbf(v0[0], v0[1]); w.y = pkbf(v0[2], v0[3]); w.z = pkbf(v1[0], v1[1]); w.w = pkbf(v1[2], v1[3]);
                    *(v4u*)(rowp + bj * 128) = w; }
            }
    }
};
struct EpiSwiglu {
    static constexpr bool PERM = true, AFTER_DRAIN = false;
    bf16* O; const float* ssq;
    __device__ __forceinline__ void operator()(const pg8::f32x4 (&acc)[2][2][4][2], const pg8::Unit& u, int wr, int wc, int fr, int fq) const {
        const int row0 = u.pm * 256 + wr * 64 + fr, col0 = u.pn * 128 + wc * 32 + 8 * fq;
#pragma unroll
        for (int ai = 0; ai < 2; ++ai)
#pragma unroll
            for (int m = 0; m < 4; ++m) {
                const int row = row0 + ai * 128 + m * 16; const float rs = row_rstd(ssq, row, fq);
                float a[8];
#pragma unroll
                for (int n = 0; n < 2; ++n)
#pragma unroll
                    for (int k = 0; k < 4; ++k) { const float g = acc[ai][0][m][n][k] * rs, up = acc[ai][1][m][n][k] * rs;
                        a[n * 4 + k] = g * __builtin_amdgcn_rcpf(1.0f + __builtin_amdgcn_exp2f(-g * LOG2E)) * up; }
                v4u w; w.x = pkbf(a[0], a[1]); w.y = pkbf(a[2], a[3]); w.z = pkbf(a[4], a[5]); w.w = pkbf(a[6], a[7]);
                *(v4u*)(O + (size_t)row * DFF + col0) = w;
            }
    }
};
struct EpiResid {
    static constexpr bool PERM = false, AFTER_DRAIN = false;
    float* x; bf16* xb; float* ssq;
    __device__ __forceinline__ void operator()(const pg8::f32x4 (&acc)[2][2][4][2], const pg8::Unit& u, int wr, int wc, int fr, int fq) const {
        const int row0 = u.pm * 256 + wr * 64 + fr, col0 = u.pn * 256 + wc * 32 + 4 * fq;
#pragma unroll
        for (int ai = 0; ai < 2; ++ai)
#pragma unroll
            for (int m = 0; m < 4; ++m) {
                const int row = row0 + ai * 128 + m * 16; float* xr = x + (size_t)row * DM + col0; bf16* br = xb + (size_t)row * DM + col0; float ss = 0.f;
#pragma unroll
                for (int bj = 0; bj < 2; ++bj)
#pragma unroll
                    for (int n = 0; n < 2; ++n) { const int off = bj * 128 + n * 16; const f32x4 v = *(const f32x4*)(xr + off) + acc[ai][bj][m][n];
                        *(f32x4*)(xr + off) = v; v2u w; w.x = pkbf(v[0], v[1]); w.y = pkbf(v[2], v[3]); *(v2u*)(br + off) = w; ss += dot4(v); }
                ss += __shfl_xor(ss, 16); ss += __shfl_xor(ss, 32);
                if (fq == 0) ssq[(size_t)row * 32 + u.pn * 4 + wc] = ss;
            }
    }
};

__device__ __forceinline__ void p0_item(const float* __restrict__ W, int K, int N, bf16* WT, const float* g, int mode, LAS float* scr, int item, int lane) {
    const int nblk = N >> 6, kb = item / nblk, nb = item - kb * nblk, k0 = kb << 6, n0 = nb << 6;
    f32x4 v[16];
    const float* src = W + (size_t)(k0 + (lane >> 4)) * N + n0 + 4 * (lane & 15);
#pragma unroll
    for (int i = 0; i < 16; ++i) v[i] = *(const f32x4*)(src + (size_t)(4 * i) * N);
#pragma unroll
    for (int i = 0; i < 16; ++i) { LAS float* d = scr + (4 * i + (lane >> 4)) * 65 + 4 * (lane & 15); d[0] = v[i][0]; d[1] = v[i][1]; d[2] = v[i][2]; d[3] = v[i][3]; }
    LDS_WAIT();
    const int c = lane & 7;
    f32x4 g0 = {1.f, 1.f, 1.f, 1.f}, g1 = {1.f, 1.f, 1.f, 1.f};
    if (g) { g0 = *(const f32x4*)(g + k0 + 8 * c); g1 = *(const f32x4*)(g + k0 + 8 * c + 4); }
#pragma unroll
    for (int j = 0; j < 8; ++j) {
        const int n = (lane >> 3) + 8 * j; const LAS float* s = scr + (8 * c) * 65 + n;
        v4u o; o.x = pkbf(s[0] * g0[0], s[65] * g0[1]); o.y = pkbf(s[130] * g0[2], s[195] * g0[3]); o.z = pkbf(s[260] * g1[0], s[325] * g1[1]); o.w = pkbf(s[390] * g1[2], s[455] * g1[3]);
        const int nn = n0 + n; const int row = (mode == 0) ? nn : (((nn >> 7) << 8) + (nn & 127) + (mode == 2 ? 128 : 0));
        *(v4u*)(WT + (size_t)row * K + k0 + 8 * c) = o;
    }
    LDS_WAIT();
}

struct Args {
    const float* x; const float* attn_norm; const float* w_in; const float* sinks; const float* out_norm_a; const float* out_norm_b;
    const float* w_out; const float* ffn_norm; const float* w_gate; const float* w_up; const float* w_down; const float* final_norm;
    float* out; unsigned char* ws; int ph_lo, ph_hi;
};

__device__ __forceinline__ void p0_phase(const Args& a, LAS unsigned char* lds, int wave, int lane) {
    LAS float* scr = (LAS float*)(lds + wave * 16640);
    const int gw = blockIdx.x * NWAVES + wave, NGW = gridDim.x * NWAVES;
    constexpr int I_IN = (DM / 64) * (IN_COLS / 64), I_OUT = (DM / 64) * (DM / 64), I_G = (DM / 64) * (DFF / 64), I_D = (DFF / 64) * (DM / 64);
    constexpr int I_LAYER = I_IN + I_OUT + 2 * I_G + I_D;
    for (int it = gw; it < DEPTH * I_LAYER; it += NGW) {
        const int l = it / I_LAYER; int r = it - l * I_LAYER;
        if (r < I_IN) { p0_item(a.w_in + (size_t)l * DM * IN_COLS, DM, IN_COLS, (bf16*)(a.ws + WS_WIN + l * SZ_WIN), a.attn_norm + l * DM, 0, scr, r, lane); continue; } r -= I_IN;
        if (r < I_OUT) { p0_item(a.w_out + (size_t)l * DM * DM, DM, DM, (bf16*)(a.ws + WS_WOUT + l * SZ_WOUT), nullptr, 0, scr, r, lane); continue; } r -= I_OUT;
        if (r < I_G) { p0_item(a.w_gate + (size_t)l * DM * DFF, DM, DFF, (bf16*)(a.ws + WS_WGU + l * SZ_WGU), a.ffn_norm + l * DM, 1, scr, r, lane); continue; } r -= I_G;
        if (r < I_G) { p0_item(a.w_up + (size_t)l * DM * DFF, DM, DFF, (bf16*)(a.ws + WS_WGU + l * SZ_WGU), a.ffn_norm + l * DM, 2, scr, r, lane); continue; } r -= I_G;
        p0_item(a.w_down + (size_t)l * DFF * DM, DFF, DM, (bf16*)(a.ws + WS_WDN + l * SZ_WDN), nullptr, 0, scr, r, lane);
    }
    bf16* xb = (bf16*)(a.ws + WS_XB); float* ssq = (float*)(a.ws + WS_SSQ);
    for (int m = gw; m < T; m += NGW) {
        const f32x4* xr = (const f32x4*)(a.x + (size_t)m * DM) + lane; f32x4 v[8]; float ss = 0.f;
#pragma unroll
        for (int j = 0; j < 8; ++j) { v[j] = xr[64 * j]; ss += dot4(v[j]); }
        ss = wave_sum(ss);
        f32x4* orow = (f32x4*)(a.out + (size_t)m * DM) + lane; v2u* brow = (v2u*)(xb + (size_t)m * DM) + lane;
#pragma unroll
        for (int j = 0; j < 8; ++j) { orow[64 * j] = v[j]; v2u w; w.x = pkbf(v[j][0], v[j][1]); w.y = pkbf(v[j][2], v[j][3]); brow[64 * j] = w; }
        if (lane < 32) ssq[(size_t)m * 32 + lane] = (lane == 0) ? ss : 0.f;
    }
}

constexpr int KV_PITCH = 144, KV_ROWS = 272, LDS_KOFF = 0, LDS_VOFF = KV_ROWS * KV_PITCH;
constexpr int N_UNITS_A = 3 * 1024, N_UNITS = N_UNITS_A + 1024;
__device__ __forceinline__ v4i16_t vtr(const LAS unsigned char* p) { return __builtin_amdgcn_ds_read_tr16_b64_v4i16((LAS v4i16_t*)p); }

__device__ __forceinline__ void attn_unit(LAS unsigned char* lds, const bf16* __restrict__ proj, int idx, const float* sinks_l,
                                          bf16* oA, bf16* oB, float* mA, float* lA, int tid, int wave, int lane) {
    int d, b, r, qt, qcol, kcol, vcol, br, hh; float slope, maxd, sink_l2 = 0.f;
    if (idx < N_UNITS_A) {
        br = idx >> 10; const int rem = idx & 1023; d = (br == 0) ? 1 : (br == 1 ? 4 : 16);
        b = rem >> 8; hh = (rem >> 4) & 15; const int nqt = 16 / d, w16 = rem & 15; r = w16 / nqt; qt = w16 - r * nqt;
        qcol = C_QA + hh * 64; kcol = C_KA + hh * 64; vcol = C_VA + hh * 64;
        slope = __builtin_amdgcn_exp2f(-(float)(2 * hh + 1) * 0.25f); maxd = 128.f;
    } else {
        br = 3; const int rem = idx - N_UNITS_A; d = 1; r = 0;
        b = rem >> 8; const int g = (rem >> 7) & 1, rr = (rem >> 4) & 7; qt = rem & 15; hh = g * 8 + rr;
        qcol = C_QB + hh * 64; kcol = C_KB + g * 64; vcol = C_VB + g * 64;
        slope = __builtin_amdgcn_exp2f(-(float)(hh + 1) * 0.5f); maxd = 127.f;
        sink_l2 = sinks_l[hh] * LOG2E;
    }
    const float sl2 = slope * (float)d * LOG2E;
    const float C2 = 0.125f * LOG2E;
    const int fr = lane & 15, fq = lane >> 4;
    {
        const int c8 = tid & 7, r0 = tid >> 3;
#pragma unroll
        for (int i = 0; i < 4; ++i) {
            const int row = r0 + 64 * i, ks = 128 * qt - 128 + row;
            v4u kv = {0u, 0u, 0u, 0u}, vv = {0u, 0u, 0u, 0u};
            if (ks >= 0) { const bf16* p = proj + (size_t)(b * SEQ + r + d * ks) * IN_COLS + 8 * c8; kv = *(const v4u*)(p + kcol); vv = *(const v4u*)(p + vcol); }
            *(LAS v4u*)(lds + LDS_KOFF + row * KV_PITCH + 16 * c8) = kv;
            *(LAS v4u*)(lds + LDS_VOFF + row * KV_PITCH + 16 * c8) = vv;
        }
        if (tid < 128) { const int row = 256 + (tid >> 3); const v4u z = {0u, 0u, 0u, 0u};
            *(LAS v4u*)(lds + LDS_KOFF + row * KV_PITCH + 16 * c8) = z; *(LAS v4u*)(lds + LDS_VOFF + row * KV_PITCH + 16 * c8) = z; }
    }
    const int iq = 128 * qt + 16 * wave + fr;
    const size_t grow = (size_t)(b * SEQ + r + d * iq);
    const bf16* qp = proj + grow * IN_COLS + qcol + 8 * fq;
    const bf16x8 q0 = *(const bf16x8*)qp, q1 = *(const bf16x8*)(qp + 32);
    __syncthreads();
    f32x4 sc[9];
    {
        const LAS unsigned char* kb = lds + LDS_KOFF + (16 * wave + fr) * KV_PITCH + 16 * fq;
#pragma unroll
        for (int j = 0; j < 9; ++j) {
            const bf16x8 k0 = *(const LAS bf16x8*)(kb + j * 16 * KV_PITCH), k1 = *(const LAS bf16x8*)(kb + j * 16 * KV_PITCH + 64);
            f32x4 z = {0.f, 0.f, 0.f, 0.f};
            z = __builtin_amdgcn_mfma_f32_16x16x32_bf16(k0, q0, z, 0, 0, 0);
            sc[j] = __builtin_amdgcn_mfma_f32_16x16x32_bf16(k1, q1, z, 0, 0, 0);
        }
    }
    const float bl = (float)(fr - 4 * fq);
    const bool early = (qt == 0);
    float mx = -INFINITY;
#pragma unroll
    for (int j = 0; j < 9; ++j)
#pragma unroll
        for (int jj = 0; jj < 4; ++jj) {
            const float dist = (float)(128 - 16 * j - jj) + bl;
            float v = __builtin_fmaf(sc[j][jj], C2, -sl2 * dist);
            bool ok = true;
            if (j == 0) ok = dist <= maxd;
            if (j == 8) ok = dist >= 0.f;
            if (early && (wave + j < 8)) ok = false;
            v = ok ? v : -INFINITY; sc[j][jj] = v; mx = __builtin_fmaxf(mx, v);
        }
    mx = __builtin_fmaxf(mx, __shfl_xor(mx, 16)); mx = __builtin_fmaxf(mx, __shfl_xor(mx, 32));
    float lsum = 0.f;
#pragma unroll
    for (int j = 0; j < 9; ++j)
#pragma unroll
        for (int jj = 0; jj < 4; ++jj) { const float p = __builtin_amdgcn_exp2f(sc[j][jj] - mx); sc[j][jj] = p; lsum += p; }
    lsum += __shfl_xor(lsum, 16); lsum += __shfl_xor(lsum, 32);
    f32x4 o[4];
#pragma unroll
    for (int dt = 0; dt < 4; ++dt) o[dt] = (f32x4){0.f, 0.f, 0.f, 0.f};
    {
        const int q4 = (lane & 15) >> 2, p4 = lane & 3;
        const LAS unsigned char* vb = lds + LDS_VOFF + (16 * wave + 4 * fq + q4) * KV_PITCH + 8 * p4;
#pragma unroll
        for (int c = 0; c < 5; ++c) {
            v4u yw; yw.x = pkbf(sc[2 * c][0], sc[2 * c][1]); yw.y = pkbf(sc[2 * c][2], sc[2 * c][3]);
            if (c < 4) { yw.z = pkbf(sc[(c < 4) ? 2 * c + 1 : 0][0], sc[(c < 4) ? 2 * c + 1 : 0][1]); yw.w = pkbf(sc[(c < 4) ? 2 * c + 1 : 0][2], sc[(c < 4) ? 2 * c + 1 : 0][3]); }
            else { yw.z = 0u; yw.w = 0u; }
            const bf16x8 Y = __builtin_bit_cast(bf16x8, yw);
#pragma unroll
            for (int dt = 0; dt < 4; ++dt) {
                const v4i16_t lo = vtr(vb + (32 * c) * KV_PITCH + 32 * dt), hi = vtr(vb + (32 * c + 16) * KV_PITCH + 32 * dt);
                const bf16x8 X = {lo[0], lo[1], lo[2], lo[3], hi[0], hi[1], hi[2], hi[3]};
                o[dt] = __builtin_amdgcn_mfma_f32_16x16x32_bf16(X, Y, o[dt], 0, 0, 0);
            }
        }
    }
    float inv; bf16* op;
    if (br < 3) {
        inv = __builtin_amdgcn_rcpf(lsum);
        if (fq == 0) { mA[((size_t)br * T + grow) * 16 + hh] = mx; lA[((size_t)br * T + grow) * 16 + hh] = lsum; }
        op = oA + ((size_t)br * T + grow) * 1024 + hh * 64 + 4 * fq;
    } else {
        const float m2 = __builtin_fmaxf(mx, sink_l2), cf = __builtin_amdgcn_exp2f(mx - m2);
        inv = cf * __builtin_amdgcn_rcpf(lsum * cf + __builtin_amdgcn_exp2f(sink_l2 - m2));
        op = oB + grow * 1024 + hh * 64 + 4 * fq;
    }
#pragma unroll
    for (int dt = 0; dt < 4; ++dt) { v2u w; w.x = pkbf(o[dt][0] * inv, o[dt][1] * inv); w.y = pkbf(o[dt][2] * inv, o[dt][3] * inv); *(v2u*)(op + 16 * dt) = w; }
    __syncthreads();
}

__device__ __forceinline__ void merge_phase(const Args& a, int layer, int wave, int lane) {
    const bf16* oA = (const bf16*)(a.ws + WS_OA); const bf16* oB = (const bf16*)(a.ws + WS_OB);
    const float* mA = (const float*)(a.ws + WS_MA); const float* lA = (const float*)(a.ws + WS_LA);
    bf16* mix = (bf16*)(a.ws + WS_MIX);
    const float* gA = a.out_norm_a + layer * 1024 + lane * 16; const float* gB = a.out_norm_b + layer * 1024 + lane * 16;
    const int gw = blockIdx.x * NWAVES + wave, NGW = gridDim.x * NWAVES, ha = lane >> 2;
    for (int t = gw; t < T; t += NGW) {
        float wgt[3]; float mxx = -INFINITY;
#pragma unroll
        for (int i = 0; i < 3; ++i) { wgt[i] = mA[((size_t)i * T + t) * 16 + ha]; mxx = __builtin_fmaxf(mxx, wgt[i]); }
        float wsum = 0.f;
#pragma unroll
        for (int i = 0; i < 3; ++i) { wgt[i] = __builtin_amdgcn_exp2f(wgt[i] - mxx) * lA[((size_t)i * T + t) * 16 + ha]; wsum += wgt[i]; }
        const float winv = 1.0f / wsum;
        float acc[16];
#pragma unroll
        for (int k = 0; k < 16; ++k) acc[k] = 0.f;
#pragma unroll
        for (int i = 0; i < 3; ++i) {
            const v4u* p = (const v4u*)(oA + ((size_t)i * T + t) * 1024 + lane * 16); const float wi = wgt[i] * winv;
#pragma unroll
            for (int h2 = 0; h2 < 2; ++h2) { const v4u q = p[h2];
#pragma unroll
                for (int k = 0; k < 4; ++k) { acc[h2 * 8 + 2 * k] += wi * __uint_as_float(q[k] << 16); acc[h2 * 8 + 2 * k + 1] += wi * __uint_as_float(q[k] & 0xffff0000u); } }
        }
        float ss = 0.f;
#pragma unroll
        for (int k = 0; k < 16; ++k) ss += acc[k] * acc[k];
        ss = wave_sum(ss);
        float rs = __builtin_amdgcn_rsqf(ss * (1.0f / 1024.f) + EPS);
        {
            v4u o0, o1; const f32x4 g0 = *(const f32x4*)(gA), g1 = *(const f32x4*)(gA + 4), g2 = *(const f32x4*)(gA + 8), g3 = *(const f32x4*)(gA + 12);
            o0.x = pkbf(acc[0] * rs * g0[0], acc[1] * rs * g0[1]); o0.y = pkbf(acc[2] * rs * g0[2], acc[3] * rs * g0[3]);
            o0.z = pkbf(acc[4] * rs * g1[0], acc[5] * rs * g1[1]); o0.w = pkbf(acc[6] * rs * g1[2], acc[7] * rs * g1[3]);
            o1.x = pkbf(acc[8] * rs * g2[0], acc[9] * rs * g2[1]); o1.y = pkbf(acc[10] * rs * g2[2], acc[11] * rs * g2[3]);
            o1.z = pkbf(acc[12] * rs * g3[0], acc[13] * rs * g3[1]); o1.w = pkbf(acc[14] * rs * g3[2], acc[15] * rs * g3[3]);
            v4u* mp = (v4u*)(mix + (size_t)t * DM + lane * 16); mp[0] = o0; mp[1] = o1;
        }
        {
            const v4u* p = (const v4u*)(oB + (size_t)t * 1024 + lane * 16);
#pragma unroll
            for (int h2 = 0; h2 < 2; ++h2) { const v4u q = p[h2];
#pragma unroll
                for (int k = 0; k < 4; ++k) { acc[h2 * 8 + 2 * k] = __uint_as_float(q[k] << 16); acc[h2 * 8 + 2 * k + 1] = __uint_as_float(q[k] & 0xffff0000u); } }
            ss = 0.f;
#pragma unroll
            for (int k = 0; k < 16; ++k) ss += acc[k] * acc[k];
            ss = wave_sum(ss);
            rs = __builtin_amdgcn_rsqf(ss * (1.0f / 1024.f) + EPS);
            v4u o0, o1; const f32x4 g0 = *(const f32x4*)(gB), g1 = *(const f32x4*)(gB + 4), g2 = *(const f32x4*)(gB + 8), g3 = *(const f32x4*)(gB + 12);
            o0.x = pkbf(acc[0] * rs * g0[0], acc[1] * rs * g0[1]); o0.y = pkbf(acc[2] * rs * g0[2], acc[3] * rs * g0[3]);
            o0.z = pkbf(acc[4] * rs * g1[0], acc[5] * rs * g1[1]); o0.w = pkbf(acc[6] * rs * g1[2], acc[7] * rs * g1[3]);
            o1.x = pkbf(acc[8] * rs * g2[0], acc[9] * rs * g2[1]); o1.y = pkbf(acc[10] * rs * g2[2], acc[11] * rs * g2[3]);
            o1.z = pkbf(acc[12] * rs * g3[0], acc[13] * rs * g3[1]); o1.w = pkbf(acc[14] * rs * g3[2], acc[15] * rs * g3[3]);
            v4u* mp = (v4u*)(mix + (size_t)t * DM + 1024 + lane * 16); mp[0] = o0; mp[1] = o1;
        }
    }
}

__device__ __forceinline__ void final_phase(const Args& a, int wave, int lane) {
    const int gw = blockIdx.x * NWAVES + wave, NGW = gridDim.x * NWAVES;
    for (int m = gw; m < T; m += NGW) {
        f32x4* xr = (f32x4*)(a.out + (size_t)m * DM) + lane; const f32x4* gr = (const f32x4*)a.final_norm + lane; f32x4 v[8]; float ss = 0.f;
#pragma unroll
        for (int j = 0; j < 8; ++j) { v[j] = xr[64 * j]; ss += dot4(v[j]); }
        ss = wave_sum(ss);
        const float rs = __builtin_amdgcn_rsqf(ss * (1.0f / DM) + EPS);
#pragma unroll
        for (int j = 0; j < 8; ++j) xr[64 * j] = v[j] * rs * gr[64 * j];
    }
}


#define RLX_AGENT __ATOMIC_RELAXED, __HIP_MEMORY_SCOPE_AGENT
#define XB_TMO      128
#define XB_XCNT(j)  (256  + 64 * (j))
#define XB_XSUB(j)  (1280 + 64 * (j))
#define XB_XGEN(j)  (2304 + 64 * (j))
#define XB_TOP      3328
#define XB_TOPGEN   3392
#define XCD_BAR_WORDS 3456
#define XB_SPIN_CAP (1u << 18)

__device__ __forceinline__ unsigned xb_ld(unsigned* p)              { return __hip_atomic_load(p, __ATOMIC_RELAXED, __HIP_MEMORY_SCOPE_AGENT); }
__device__ __forceinline__ unsigned xb_add(unsigned* p, unsigned v) { return __hip_atomic_fetch_add(p, v, __ATOMIC_RELAXED, __HIP_MEMORY_SCOPE_AGENT); }
__device__ __forceinline__ unsigned xb_xcc_id() { return (unsigned)__builtin_amdgcn_s_getreg((3 << 11) | 20) & 0xFu; }
#define XB_SPIN(cond, bar) do { unsigned _sp = 0; while (cond) { __builtin_amdgcn_s_sleep(1); \
    if ((++_sp & 255u) == 0u) { if (xb_ld(&(bar)[XB_TMO])) break; if (_sp > XB_SPIN_CAP) { atomicAdd(&(bar)[XB_TMO], 1u); break; } } } } while (0)

struct XcdBarrier {
    unsigned* bar; unsigned x;
    volatile LAS unsigned* st;
};

__device__ __forceinline__ XcdBarrier xcd_barrier_post(unsigned* bar, volatile LAS unsigned* st) {
    XcdBarrier b; b.bar = bar; b.x = xb_xcc_id(); b.st = st;
    if (threadIdx.x == 0) (void)xb_add(&bar[XB_XCNT(b.x)], 1u);
    return b;
}
__device__ __forceinline__ void xcd_barrier_complete(unsigned* bar, unsigned x, unsigned& nloc, unsigned& nx) {
    const unsigned G = gridDim.x * gridDim.y * gridDim.z;
    unsigned sum, cnt, mine, sp = 0u;
    for (;;) {
        sum = 0u; cnt = 0u; mine = 0u;
#pragma unroll
        for (unsigned j = 0; j < 16; ++j) { const unsigned c = xb_ld(&bar[XB_XCNT(j)]); sum += c; cnt += (c > 0u) ? 1u : 0u; mine = (j == x) ? c : mine; }
        if (sum == G) break;
        __builtin_amdgcn_s_sleep(1);
        if ((++sp & 255u) == 0u) { if (xb_ld(&bar[XB_TMO])) break; if (sp > XB_SPIN_CAP) { atomicAdd(&bar[XB_TMO], 1u); break; } }
    }
    nloc = mine > 0u ? mine : 1u; nx = cnt > 0u ? cnt : 1u;
}

__device__ __forceinline__ void xcd_barrier(const XcdBarrier& b) {
    asm volatile("s_waitcnt vmcnt(0)" ::: "memory");
    __syncthreads();
    if (threadIdx.x == 0) {
        unsigned* bar = b.bar;
        __builtin_amdgcn_s_waitcnt(0);
        unsigned nloc = b.st[0], nx = b.st[1];
        if (nloc == 0u) { xcd_barrier_complete(bar, b.x, nloc, nx); b.st[0] = nloc; b.st[1] = nx; }
        const unsigned old = xb_add(&bar[XB_XSUB(b.x)], 1u);
        const unsigned gen = old / nloc;
        if (old + 1u == (gen + 1u) * nloc) {
            __builtin_amdgcn_fence(__ATOMIC_RELEASE, "agent");
            asm volatile("s_waitcnt vmcnt(0)" ::: "memory");
            const unsigned og = xb_add(&bar[XB_TOP], 1u);
            const unsigned tg = og / nx;
            if (og + 1u == (tg + 1u) * nx) xb_add(&bar[XB_TOPGEN], 1u);
            else XB_SPIN(xb_ld(&bar[XB_TOPGEN]) == tg, bar);
            __builtin_amdgcn_fence(__ATOMIC_ACQUIRE, "agent");
            xb_add(&bar[XB_XGEN(b.x)], 1u);
            asm volatile("s_waitcnt vmcnt(0)" ::: "memory");
        } else {
            XB_SPIN(xb_ld(&bar[XB_XGEN(b.x)]) == gen, bar);
            __builtin_amdgcn_fence(__ATOMIC_ACQUIRE, "agent");
            asm volatile("s_waitcnt vmcnt(0)" ::: "memory");
        }
    }
    __syncthreads();
}

#ifndef PROBE_DUP
#define PROBE_DUP -1
#endif
#ifndef PROBE_P0
#define PROBE_P0 0
#endif
constexpr int PL = 6 + (PROBE_DUP >= 0 ? 1 : 0), PH0 = 1 + PROBE_P0;
constexpr int N_PHASES = PH0 + 1 + PL * DEPTH;
__global__ void __launch_bounds__(NTHREADS, 2) fwd_megakernel(Args a) {
    extern __shared__ __attribute__((aligned(16))) unsigned char lds_raw[];
    cg::grid_group grid = cg::this_grid();
    LAS unsigned char* lds = (LAS unsigned char*)lds_raw;
    bf16* xb = (bf16*)(a.ws + WS_XB); bf16* proj = (bf16*)(a.ws + WS_PROJ); bf16* mix = (bf16*)(a.ws + WS_MIX); bf16* act = (bf16*)(a.ws + WS_ACT);
    float* ssq = (float*)(a.ws + WS_SSQ);
    volatile LAS unsigned* MISC = (volatile LAS unsigned*)(lds + MISC_OFF);
    if (threadIdx.x < 32) MISC[threadIdx.x] = 0u;
    __syncthreads();
    XcdBarrier bar = xcd_barrier_post((unsigned*)(a.ws + WS_BAR), MISC + 8);
    for (int ph = a.ph_lo; ph < a.ph_hi; ++ph) {
        int tid_l = threadIdx.x; asm volatile("" : "+v"(tid_l));
        const int tid = tid_l, lane = tid & 63, wave = __builtin_amdgcn_readfirstlane(tid >> 6);
        if (ph < PH0) p0_phase(a, lds, wave, lane);
        else if (ph == N_PHASES - 1) final_phase(a, wave, lane);
        else {
            const int l = (ph - PH0) / PL, kq = (ph - PH0) - PL * l, k = (PROBE_DUP >= 0 && kq > PROBE_DUP) ? kq - 1 : kq;
            if (k == 0) {
                pg8::Gemm g{xb, (const bf16*)(a.ws + WS_WIN + l * SZ_WIN), T, IN_COLS, DM}; pg8::StaticOrder S; S.init(T, IN_COLS, (int)gridDim.x, (int)blockIdx.x);
                EpiScaleBf16 E{proj, IN_COLS, ssq};
                pg8::gemm_phase<EpiScaleBf16, pg8::StaticOrder, true, true>(lds, g, S, E);
            } else if (k == 1) {
                for (int idx = blockIdx.x; idx < N_UNITS; idx += gridDim.x)
                    attn_unit(lds, proj, idx, a.sinks + l * 16, (bf16*)(a.ws + WS_OA), (bf16*)(a.ws + WS_OB), (float*)(a.ws + WS_MA), (float*)(a.ws + WS_LA), tid, wave, lane);
            } else if (k == 2) {
                merge_phase(a, l, wave, lane);
            } else if (k == 3) {
                pg8::Gemm g{mix, (const bf16*)(a.ws + WS_WOUT + l * SZ_WOUT), T, DM, DM}; pg8::StaticOrder S; S.init(T, DM, (int)gridDim.x, (int)blockIdx.x);
                EpiResid E{a.out, xb, ssq};
                pg8::gemm_phase<EpiResid, pg8::StaticOrder, false, true>(lds, g, S, E);
            } else if (k == 4) {
                pg8::Gemm g{xb, (const bf16*)(a.ws + WS_WGU + l * SZ_WGU), T, NGU, DM}; pg8::StaticOrder S; S.init(T, NGU, (int)gridDim.x, (int)blockIdx.x);
                EpiSwiglu E{act, ssq};
                pg8::gemm_phase<EpiSwiglu, pg8::StaticOrder, true, true>(lds, g, S, E);
            } else {
                pg8::Gemm g{act, (const bf16*)(a.ws + WS_WDN + l * SZ_WDN), T, DM, DFF}; pg8::StaticOrder S; S.init(T, DM, (int)gridDim.x, (int)blockIdx.x);
                EpiResid E{a.out, xb, ssq};
                pg8::gemm_phase<EpiResid, pg8::StaticOrder, false, true>(lds, g, S, E);
            }
        }
        if (ph + 1 < a.ph_hi) { if (ph == 0) grid.sync(); else xcd_barrier(bar); }
    }
}

extern "C" void kernel_launch(void* const* d_in, const int* in_sizes, int n_in, void* d_out, int out_size, void* d_ws, size_t ws_size, hipStream_t stream) {
    static int grid = 0;
    if (grid == 0) {
        if (n_in != 12 || in_sizes[0] != T * DM || out_size != T * DM || ws_size < WS_END) { fprintf(stderr, "kernel_launch: unexpected shapes (n_in %d, out %d, ws %zu < %zu)\n", n_in, out_size, ws_size, (size_t)WS_END); grid = -1; return; }
        int dev = 0, cus = 0, per_cu = 0;
        if (hipGetDevice(&dev) != hipSuccess || hipDeviceGetAttribute(&cus, hipDeviceAttributeMultiprocessorCount, dev) != hipSuccess) { grid = -1; return; }
        if (hipFuncSetAttribute((const void*)fwd_megakernel, hipFuncAttributeMaxDynamicSharedMemorySize, LDS_BYTES) != hipSuccess) { fprintf(stderr, "kernel_launch: hipFuncSetAttribute failed\n"); grid = -1; return; }
        if (hipOccupancyMaxActiveBlocksPerMultiprocessor(&per_cu, (const void*)fwd_megakernel, NTHREADS, LDS_BYTES) != hipSuccess || per_cu < 1) per_cu = 1;
        (void)hipGetLastError();
        grid = cus * per_cu;
    }
    if (grid < 0) return;
    if (hipMemsetAsync((unsigned char*)d_ws + WS_BAR, 0, BAR_BYTES, stream) != hipSuccess) { fprintf(stderr, "kernel_launch: memset of the barrier words failed\n"); return; }
    Args a{};
    a.x = (const float*)d_in[0]; a.attn_norm = (const float*)d_in[1]; a.w_in = (const float*)d_in[2]; a.sinks = (const float*)d_in[3];
    a.out_norm_a = (const float*)d_in[4]; a.out_norm_b = (const float*)d_in[5]; a.w_out = (const float*)d_in[6]; a.ffn_norm = (const float*)d_in[7];
    a.w_gate = (const float*)d_in[8]; a.w_up = (const float*)d_in[9]; a.w_down = (const float*)d_in[10]; a.final_norm = (const float*)d_in[11];
    a.out = (float*)d_out; a.ws = (unsigned char*)d_ws; a.ph_lo = 0; a.ph_hi = N_PHASES;
    void* args[] = {&a};
    const hipError_t e = hipLaunchCooperativeKernel((const void*)fwd_megakernel, dim3(grid), dim3(NTHREADS), args, LDS_BYTES, stream);
    if (e != hipSuccess) fprintf(stderr, "kernel_launch: cooperative launch failed: %s (grid %d)\n", hipGetErrorString(e), grid);
}
```

```cpp
#include <hip/hip_runtime.h>
#include <hip/hip_cooperative_groups.h>
#include <cstdio>
#include <cstdint>
namespace cg = cooperative_groups;
namespace pg8 {
#define PG8_LAS __attribute__((address_space(3)))
typedef unsigned short bf16_t;
typedef short bf16x8 __attribute__((ext_vector_type(8)));
typedef float f32x4 __attribute__((ext_vector_type(4)));
typedef unsigned u32x4 __attribute__((ext_vector_type(4)));
constexpr int BM = 256, BK = 64, HALF = 128, HTB = HALF * BK * 2  , STAGE_BYTES = 8 * HTB, NXCD = 8, WGM = 8;

__host__ __device__ __forceinline__ int lds_byte(int r, int c) { const int st = (r >> 4) * 2 + (c >> 5), rr = r & 15, cc = c & 31, ob = rr * 64 + cc * 2; return st * 1024 + (ob ^ (((ob >> 9) & 1) << 5)); }
__host__ __device__ __forceinline__ void stage_rc(int b, int& R, int& C) { const int st = b / 1024, sb = b % 1024, swz = sb ^ (((sb >> 9) & 1) << 5); R = (st >> 1) * 16 + swz / 64; C = (st & 1) * 32 + (swz % 64) / 2; }
__host__ __device__ __forceinline__ int perm32(int rho) { const int n = rho >> 4, i = rho & 15; return 8 * (i >> 2) + 4 * n + (i & 3); }

struct Unit { int pm, pn; };
struct Gemm { const bf16_t* A; const bf16_t* Bt; int M, N, K; };

struct StaticOrder {
    int nM, nN, nwg, G, c;
    __host__ __device__ void init(int M, int N, int G_, int c_) { nM = M / BM; nN = N / BM; nwg = nM * nN; G = G_; c = c_; }
    __host__ __device__ bool next(int i, Unit& u) const {
        const long L = (long)i * G + c; if (L >= nwg) return false;
        int wgid = (int)L; { const int q = nwg / NXCD, r = nwg % NXCD, xcd = wgid % NXCD, off = wgid / NXCD; wgid = (xcd < r ? xcd * (q + 1) : r * (q + 1) + (xcd - r) * q) + off; }
        const int nig = WGM * nN, gid = wgid / nig, fm = gid * WGM, gsz = (nM - fm) < WGM ? (nM - fm) : WGM;
        u.pm = fm + ((wgid % nig) % gsz); u.pn = (wgid % nig) / gsz; return true;
    }
    __device__ __forceinline__ void a_ready(const Unit&) const {}
    __device__ __forceinline__ void done(const Unit&) const {}
};

__device__ __forceinline__ unsigned cvt_pk_bf16(float lo, float hi) { unsigned r; asm volatile("v_cvt_pk_bf16_f32 %0, %1, %2" : "=v"(r) : "v"(lo), "v"(hi)); return r; }
typedef float f32x2 __attribute__((ext_vector_type(2)));
template <class Epi, class Sched, bool ALIGN_EPI = false, bool SP2 = false>
__device__ __forceinline__ void gemm_phase(PG8_LAS unsigned char* lds, const Gemm g, const Sched& S, const Epi& E) {
    int tid_l = threadIdx.x; asm volatile("" : "+v"(tid_l));
    const int tid = tid_l, wid = __builtin_amdgcn_readfirstlane(tid >> 6), lane = tid & 63, wr = wid >> 2, wc = wid & 3, fr = lane & 15, fq = lane >> 4;
    const int K = g.K, nt = K / BK;
    unsigned voffA[2], voffB[2];
#pragma unroll
    for (int i = 0; i < 2; ++i) { int R, C; stage_rc(tid * 16 + i * 8192, R, C); const int Rb = Epi::PERM ? ((R & ~31) + perm32(R & 31)) : R;
        voffA[i] = (unsigned)(R * K + C) * 2u; voffB[i] = (unsigned)(Rb * K + C) * 2u; }
    const size_t kstep = (size_t)(BK * 2);
    const size_t hstep = (size_t)HALF * K * 2;
    const size_t tstep = 2 * hstep;
    const unsigned ldsw = (unsigned)wid * 1024u;
    const int aoff = lds_byte(wr * 64 + fr, fq * 8), boff = lds_byte(wc * 32 + fr, fq * 8);
#define PG8_SA(b, h) (((b) * 2 + (h)) * HTB)
#define PG8_SB(b, h) ((4 + (b) * 2 + (h)) * HTB)
#define PG8_STAGE(bufoff, gbase, voff) do { _Pragma("unroll") for (int _i = 0; _i < 2; ++_i) \
        __builtin_amdgcn_global_load_lds((const unsigned*)((const char*)(gbase) + (voff)[_i]), (PG8_LAS unsigned*)(lds + (bufoff) + ldsw + _i * 8192), 16, 0, 0); } while (0)
#define PG8_LDA(dst, b, h) do { _Pragma("unroll") for (int m = 0; m < 4; ++m) _Pragma("unroll") for (int k = 0; k < 2; ++k) dst[m][k] = *(const PG8_LAS bf16x8*)(lds + PG8_SA(b, h) + aoff + m * 2048 + k * 1024); } while (0)
#define PG8_LDB(dst, b, h) do { _Pragma("unroll") for (int n = 0; n < 2; ++n) _Pragma("unroll") for (int k = 0; k < 2; ++k) dst[n][k] = *(const PG8_LAS bf16x8*)(lds + PG8_SB(b, h) + boff + n * 2048 + k * 1024); } while (0)
#define PG8_MMA(ai, bj, At, Bt) do { __builtin_amdgcn_s_setprio(1); _Pragma("unroll") for (int m = 0; m < 4; ++m) _Pragma("unroll") for (int n = 0; n < 2; ++n) _Pragma("unroll") for (int k = 0; k < 2; ++k) \
        acc[ai][bj][m][n] = __builtin_amdgcn_mfma_f32_16x16x32_bf16(Bt[n][k], At[m][k], acc[ai][bj][m][n], 0, 0, 0); __builtin_amdgcn_s_setprio(0); } while (0)
#define PG8_WAIT_V(n) asm volatile("s_waitcnt vmcnt(" #n ")" ::: "memory")
#define PG8_WAIT_L(n) asm volatile("s_waitcnt lgkmcnt(" #n ")" ::: "memory")
#define PG8_BAR __builtin_amdgcn_s_barrier()
#define PG8_SCHED __builtin_amdgcn_sched_barrier(0)
    Unit cur, nxt; int ui = 0;
    if (!S.next(0, cur)) return;
    f32x4 acc[2][2][4][2];
#pragma unroll
    for (int a = 0; a < 2; ++a)
#pragma unroll
        for (int b = 0; b < 2; ++b)
#pragma unroll
            for (int m = 0; m < 4; ++m)
#pragma unroll
                for (int n = 0; n < 2; ++n) acc[a][b][m][n] = (f32x4){0.f, 0.f, 0.f, 0.f};
    bf16x8 At[4][2], B0[2][2], B1[2][2];
    const char* cA = (const char*)g.A + (size_t)cur.pm * tstep; const char* cB = (const char*)g.Bt + (size_t)cur.pn * tstep;
    S.a_ready(cur);
    if constexpr (SP2) {
        PG8_STAGE(PG8_SB(0, 0), cB, voffB); PG8_STAGE(PG8_SB(0, 1), cB + hstep, voffB); PG8_STAGE(PG8_SA(0, 0), cA, voffA); PG8_STAGE(PG8_SA(0, 1), cA + hstep, voffA);
        if (wr == 1) PG8_BAR;
        PG8_WAIT_V(2); PG8_BAR;
        PG8_STAGE(PG8_SB(1, 0), cB + kstep, voffB); PG8_STAGE(PG8_SA(1, 0), cA + kstep, voffA); PG8_STAGE(PG8_SB(1, 1), cB + hstep + kstep, voffB);
        PG8_WAIT_V(6); PG8_BAR;
    } else {
        PG8_STAGE(PG8_SB(0, 0), cB, voffB); PG8_STAGE(PG8_SA(0, 0), cA, voffA); PG8_STAGE(PG8_SB(0, 1), cB + hstep, voffB); PG8_STAGE(PG8_SA(0, 1), cA + hstep, voffA);
        if (wr == 1) PG8_BAR;
        PG8_WAIT_V(4); PG8_BAR;
        PG8_STAGE(PG8_SB(1, 0), cB + kstep, voffB); PG8_STAGE(PG8_SA(1, 0), cA + kstep, voffA); PG8_STAGE(PG8_SB(1, 1), cB + hstep + kstep, voffB);
        PG8_WAIT_V(6); PG8_BAR;
    }
    for (;;) {
        const bool has_next = S.next(ui + 1, nxt);
        const char* nA = has_next ? (const char*)g.A + (size_t)nxt.pm * tstep : cA; const char* nB = has_next ? (const char*)g.Bt + (size_t)nxt.pn * tstep : cB;
        for (int t = 0; t < nt; t += 2) {
            const bool last = (t == nt - 2);
            const char* a1 = cA + (size_t)(t + 1) * kstep;
            const char* a2 = last ? nA : cA + (size_t)(t + 2) * kstep; const char* b2 = last ? nB : cB + (size_t)(t + 2) * kstep;
            const char* a3 = a2 + kstep; const char* b3 = b2 + kstep;
            if (last && has_next) S.a_ready(nxt);
            if constexpr (SP2) {
            PG8_LDB(B0, 0, 0); PG8_LDB(B1, 0, 1); PG8_SCHED; PG8_LDA(At, 0, 0); PG8_STAGE(PG8_SA(1, 1), a1 + hstep, voffA);
            PG8_WAIT_V(8); PG8_WAIT_L(0); PG8_BAR; PG8_MMA(0, 0, At, B0); PG8_MMA(0, 1, At, B1); PG8_BAR; PG8_SCHED;
            PG8_LDA(At, 0, 1); PG8_STAGE(PG8_SB(0, 0), b2, voffB); PG8_STAGE(PG8_SB(0, 1), b2 + hstep, voffB); PG8_STAGE(PG8_SA(0, 0), a2, voffA);
            PG8_WAIT_V(8); PG8_WAIT_L(0); PG8_BAR; PG8_MMA(1, 0, At, B0); PG8_MMA(1, 1, At, B1); PG8_BAR; PG8_SCHED;
            PG8_LDB(B0, 1, 0); PG8_LDB(B1, 1, 1); PG8_SCHED; PG8_LDA(At, 1, 0); PG8_STAGE(PG8_SA(0, 1), a2 + hstep, voffA);
            PG8_WAIT_V(8); PG8_WAIT_L(0); PG8_BAR; PG8_MMA(0, 0, At, B0); PG8_MMA(0, 1, At, B1); PG8_BAR; PG8_SCHED;
            PG8_LDA(At, 1, 1); PG8_STAGE(PG8_SB(1, 0), b3, voffB); PG8_STAGE(PG8_SB(1, 1), b3 + hstep, voffB); PG8_STAGE(PG8_SA(1, 0), a3, voffA);
            PG8_WAIT_V(8); PG8_WAIT_L(0); PG8_BAR; PG8_MMA(1, 0, At, B0); PG8_MMA(1, 1, At, B1); PG8_BAR; PG8_SCHED;
            } else {
            PG8_LDB(B0, 0, 0); PG8_SCHED; PG8_LDA(At, 0, 0); PG8_STAGE(PG8_SA(1, 1), a1 + hstep, voffA);
            PG8_WAIT_L(8); PG8_BAR; PG8_WAIT_L(0); PG8_MMA(0, 0, At, B0); PG8_BAR; PG8_SCHED;
            PG8_LDB(B1, 0, 1); PG8_STAGE(PG8_SB(0, 0), b2, voffB);
            PG8_BAR; PG8_WAIT_L(0); PG8_MMA(0, 1, At, B1); PG8_BAR;
            PG8_LDA(At, 0, 1); PG8_STAGE(PG8_SA(0, 0), a2, voffA);
            PG8_BAR; PG8_WAIT_L(0); PG8_MMA(1, 0, At, B0); PG8_BAR; PG8_SCHED;
            PG8_STAGE(PG8_SB(0, 1), b2 + hstep, voffB);
            PG8_WAIT_V(6); PG8_BAR; PG8_MMA(1, 1, At, B1); PG8_BAR;
            PG8_LDB(B0, 1, 0); PG8_SCHED; PG8_LDA(At, 1, 0); PG8_STAGE(PG8_SA(0, 1), a2 + hstep, voffA);
            PG8_WAIT_L(8); PG8_BAR; PG8_WAIT_L(0); PG8_MMA(0, 0, At, B0); PG8_BAR; PG8_SCHED;
            PG8_LDB(B1, 1, 1); PG8_STAGE(PG8_SB(1, 0), b3, voffB);
            PG8_BAR; PG8_WAIT_L(0); PG8_MMA(0, 1, At, B1); PG8_BAR;
            PG8_LDA(At, 1, 1); PG8_STAGE(PG8_SA(1, 0), a3, voffA);
            PG8_BAR; PG8_WAIT_L(0); PG8_MMA(1, 0, At, B0); PG8_BAR; PG8_SCHED;
            PG8_STAGE(PG8_SB(1, 1), b3 + hstep, voffB);
            PG8_WAIT_V(6); PG8_BAR; PG8_MMA(1, 1, At, B1); PG8_BAR;
            }
        }
        if constexpr (ALIGN_EPI) { if (wr == 0) PG8_BAR; }
        if constexpr (!Epi::AFTER_DRAIN) { E(acc, cur, wr, wc, fr, fq); S.done(cur); }
        if (!has_next) break;
#pragma unroll
        for (int a = 0; a < 2; ++a)
#pragma unroll
            for (int b = 0; b < 2; ++b)
#pragma unroll
                for (int m = 0; m < 4; ++m)
#pragma unroll
                    for (int n = 0; n < 2; ++n) acc[a][b][m][n] = (f32x4){0.f, 0.f, 0.f, 0.f};
        cur = nxt; cA = nA; cB = nB; ++ui;
        if constexpr (ALIGN_EPI) { if (wr == 1) PG8_BAR; }
    }
    PG8_WAIT_V(0);
    if constexpr (!ALIGN_EPI) { if (wr == 0) PG8_BAR; }
    PG8_BAR;
    if constexpr (Epi::AFTER_DRAIN) { E.fused(acc, cur, wr, wc, fr, fq, lds, wid, lane); S.done(cur); }
#undef PG8_SA
#undef PG8_SB
#undef PG8_STAGE
#undef PG8_LDA
#undef PG8_LDB
#undef PG8_MMA
#undef PG8_WAIT_V
#undef PG8_WAIT_L
#undef PG8_BAR
#undef PG8_SCHED
}
}

#define LAS __attribute__((address_space(3)))
typedef unsigned short bf16;
typedef unsigned v4u __attribute__((ext_vector_type(4)));
typedef unsigned v2u __attribute__((ext_vector_type(2)));
typedef float f32x4 __attribute__((ext_vector_type(4)));
typedef short bf16x8 __attribute__((ext_vector_type(8)));
typedef short v4i16_t __attribute__((ext_vector_type(4)));

constexpr int BATCH = 4, SEQ = 2048, DM = 2048, DEPTH = 4;
constexpr int T = BATCH * SEQ;
constexpr int IN_COLS = 4352, DFF = 5632, NGU = 2 * DFF;
constexpr int C_QA = 0, C_KA = 1024, C_VA = 2048, C_QB = 3072, C_KB = 4096, C_VB = 4224;
constexpr float EPS = 1e-6f, LOG2E = 1.4426950408889634f;
constexpr int NWAVES = 8, NTHREADS = 512;
constexpr int LDS_BYTES = 136 * 1024;

constexpr size_t SZ_WIN = (size_t)IN_COLS * DM * 2, SZ_WOUT = (size_t)DM * DM * 2, SZ_WGU = (size_t)NGU * DM * 2, SZ_WDN = (size_t)DM * DFF * 2;
constexpr size_t WS_WIN = 0;
constexpr size_t WS_WOUT = WS_WIN + DEPTH * SZ_WIN;
constexpr size_t WS_WGU = WS_WOUT + DEPTH * SZ_WOUT;
constexpr size_t WS_WDN = WS_WGU + DEPTH * SZ_WGU;
constexpr size_t WS_XB = WS_WDN + DEPTH * SZ_WDN;
constexpr size_t WS_PROJ = WS_XB + (size_t)T * DM * 2;
constexpr size_t WS_OA = WS_PROJ + (size_t)T * IN_COLS * 2;
constexpr size_t WS_OB = WS_OA + 3 * (size_t)T * 1024 * 2;
constexpr size_t WS_MIX = WS_OB + (size_t)T * 1024 * 2;
constexpr size_t WS_ACT = WS_MIX + (size_t)T * DM * 2;
constexpr size_t WS_SSQ = WS_ACT + (size_t)T * DFF * 2;
constexpr size_t WS_MA = WS_SSQ + (size_t)T * 32 * 4;
constexpr size_t WS_LA = WS_MA + 3 * (size_t)T * 16 * 4;
constexpr size_t WS_BAR = WS_LA + 3 * (size_t)T * 16 * 4;
constexpr size_t BAR_BYTES = 16384;
constexpr size_t WS_END = WS_BAR + BAR_BYTES;
constexpr int MISC_OFF = 135168;

#define LDS_WAIT() asm volatile("s_waitcnt lgkmcnt(0)" ::: "memory")
__device__ __forceinline__ unsigned pkbf(float lo, float hi) { return pg8::cvt_pk_bf16(lo, hi); }
__device__ __forceinline__ float wave_sum(float v) {
#pragma unroll
    for (int o = 1; o < 64; o <<= 1) v += __shfl_xor(v, o);
    return v;
}
__device__ __forceinline__ float dot4(f32x4 v) { return (v[0] * v[0] + v[1] * v[1]) + (v[2] * v[2] + v[3] * v[3]); }

__device__ __forceinline__ void rows_rstd(float (&rs)[2][4], const float* ssq, int row0, int fq) {
    f32x4 pa[2][4], pb[2][4];
#pragma unroll
    for (int ai = 0; ai < 2; ++ai)
#pragma unroll
        for (int m = 0; m < 4; ++m) { const float* p = ssq + (size_t)(row0 + ai * 128 + m * 16) * 32 + 8 * fq; pa[ai][m] = *(const f32x4*)p; pb[ai][m] = *(const f32x4*)(p + 4); }
#pragma unroll
    for (int ai = 0; ai < 2; ++ai)
#pragma unroll
        for (int m = 0; m < 4; ++m) { const f32x4 a = pa[ai][m], b = pb[ai][m];
            float s = ((a[0] + a[1]) + (a[2] + a[3])) + ((b[0] + b[1]) + (b[2] + b[3]));
            s += __shfl_xor(s, 16); s += __shfl_xor(s, 32);
            rs[ai][m] = __builtin_amdgcn_rsqf(s * (1.0f / DM) + EPS); }
}
struct EpiScaleBf16 {
    static constexpr bool PERM = true, AFTER_DRAIN = false;
    bf16* O; int ldc; const float* ssq;
    __device__ __forceinline__ void operator()(const pg8::f32x4 (&acc)[2][2][4][2], const pg8::Unit& u, int wr, int wc, int fr, int fq) const {
        const int row0 = u.pm * 256 + wr * 64 + fr, col0 = u.pn * 256 + wc * 32 + 8 * fq;
        float rs[2][4]; rows_rstd(rs, ssq, row0, fq);
#pragma unroll
        for (int ai = 0; ai < 2; ++ai)
#pragma unroll
            for (int m = 0; m < 4; ++m) {
                const int row = row0 + ai * 128 + m * 16; bf16* rowp = O + (size_t)row * ldc + col0;
#pragma unroll
                for (int bj = 0; bj < 2; ++bj) { const f32x4 v0 = acc[ai][bj][m][0] * rs[ai][m], v1 = acc[ai][bj][m][1] * rs[ai][m];
                    v4u w; w.x = pkbf(v0[0], v0[1]); w.y = pkbf(v0[2], v0[3]); w.z = pkbf(v1[0], v1[1]); w.w = pkbf(v1[2], v1[3]);
                    *(v4u*)(rowp + bj * 128) = w; }
            }
    }
};
struct EpiSwiglu {
    static constexpr bool PERM = true, AFTER_DRAIN = false;
    bf16* O; const float* ssq;
    __device__ __forceinline__ void operator()(const pg8::f32x4 (&acc)[2][2][4][2], const pg8::Unit& u, int wr, int wc, int fr, int fq) const {
        const int row0 = u.pm * 256 + wr * 64 + fr, col0 = u.pn * 128 + wc * 32 + 8 * fq;
        float rs[2][4]; rows_rstd(rs, ssq, row0, fq);
#pragma unroll
        for (int ai = 0; ai < 2; ++ai)
#pragma unroll
            for (int m = 0; m < 4; ++m) {
                const int row = row0 + ai * 128 + m * 16; const float r1 = rs[ai][m];
                float a[8];
#pragma unroll
                for (int n = 0; n < 2; ++n)
#pragma unroll
                    for (int k = 0; k < 4; ++k) { const float g = acc[ai][0][m][n][k] * r1, up = acc[ai][1][m][n][k] * r1;
                        a[n * 4 + k] = g * __builtin_amdgcn_rcpf(1.0f + __builtin_amdgcn_exp2f(-g * LOG2E)) * up; }
                v4u w; w.x = pkbf(a[0], a[1]); w.y = pkbf(a[2], a[3]); w.z = pkbf(a[4], a[5]); w.w = pkbf(a[6], a[7]);
                *(v4u*)(O + (size_t)row * DFF + col0) = w;
            }
    }
};
struct EpiResid {
    static constexpr bool PERM = false, AFTER_DRAIN = false;
    float* x; bf16* xb; float* ssq;
    __device__ __forceinline__ void operator()(const pg8::f32x4 (&acc)[2][2][4][2], const pg8::Unit& u, int wr, int wc, int fr, int fq) const {
        const int row0 = u.pm * 256 + wr * 64 + fr, col0 = u.pn * 256 + wc * 32 + 4 * fq;
#pragma unroll
        for (int ai = 0; ai < 2; ++ai) {
            f32x4 xv[4][2][2];
#pragma unroll
            for (int m = 0; m < 4; ++m) { const float* xr = x + (size_t)(row0 + ai * 128 + m * 16) * DM + col0;
#pragma unroll
                for (int bj = 0; bj < 2; ++bj)
#pragma unroll
                    for (int n = 0; n < 2; ++n) xv[m][bj][n] = *(const f32x4*)(xr + bj * 128 + n * 16); }
#pragma unroll
            for (int m = 0; m < 4; ++m) {
                const int row = row0 + ai * 128 + m * 16; float* xr = x + (size_t)row * DM + col0; bf16* br = xb + (size_t)row * DM + col0; float ss = 0.f;
#pragma unroll
                for (int bj = 0; bj < 2; ++bj)
#pragma unroll
                    for (int n = 0; n < 2; ++n) { const int off = bj * 128 + n * 16; const f32x4 v = xv[m][bj][n] + acc[ai][bj][m][n];
                        *(f32x4*)(xr + off) = v; v2u w; w.x = pkbf(v[0], v[1]); w.y = pkbf(v[2], v[3]); *(v2u*)(br + off) = w; ss += dot4(v); }
                ss += __shfl_xor(ss, 16); ss += __shfl_xor(ss, 32);
                if (fq == 0) ssq[(size_t)row * 32 + u.pn * 4 + wc] = ss;
            }
        }
    }
};

__device__ __forceinline__ void p0_item(const float* __restrict__ W, int K, int N, bf16* WT, const float* g, int mode, LAS float* scr, int item, int lane) {
    const int nblk = N >> 6, kb = item / nblk, nb = item - kb * nblk, k0 = kb << 6, n0 = nb << 6;
    f32x4 v[16];
    const float* src = W + (size_t)(k0 + (lane >> 4)) * N + n0 + 4 * (lane & 15);
#pragma unroll
    for (int i = 0; i < 16; ++i) v[i] = *(const f32x4*)(src + (size_t)(4 * i) * N);
#pragma unroll
    for (int i = 0; i < 16; ++i) { LAS float* d = scr + (4 * i + (lane >> 4)) * 65 + 4 * (lane & 15); d[0] = v[i][0]; d[1] = v[i][1]; d[2] = v[i][2]; d[3] = v[i][3]; }
    LDS_WAIT();
    const int c = lane & 7;
    f32x4 g0 = {1.f, 1.f, 1.f, 1.f}, g1 = {1.f, 1.f, 1.f, 1.f};
    if (g) { g0 = *(const f32x4*)(g + k0 + 8 * c); g1 = *(const f32x4*)(g + k0 + 8 * c + 4); }
#pragma unroll
    for (int j = 0; j < 8; ++j) {
        const int n = (lane >> 3) + 8 * j; const LAS float* s = scr + (8 * c) * 65 + n;
        v4u o; o.x = pkbf(s[0] * g0[0], s[65] * g0[1]); o.y = pkbf(s[130] * g0[2], s[195] * g0[3]); o.z = pkbf(s[260] * g1[0], s[325] * g1[1]); o.w = pkbf(s[390] * g1[2], s[455] * g1[3]);
        const int nn = n0 + n; const int row = (mode == 0) ? nn : (((nn >> 7) << 8) + (nn & 127) + (mode == 2 ? 128 : 0));
        *(v4u*)(WT + (size_t)row * K + k0 + 8 * c) = o;
    }
    LDS_WAIT();
}

struct Args {
    const float* x; const float* attn_norm; const float* w_in; const float* sinks; const float* out_norm_a; const float* out_norm_b;
    const float* w_out; const float* ffn_norm; const float* w_gate; const float* w_up; const float* w_down; const float* final_norm;
    float* out; unsigned char* ws; int ph_lo, ph_hi;
};

__device__ __forceinline__ void p0_phase(const Args& a, LAS unsigned char* lds, int wave, int lane) {
    LAS float* scr = (LAS float*)(lds + wave * 16640);
    const int gw = blockIdx.x * NWAVES + wave, NGW = gridDim.x * NWAVES;
    constexpr int I_IN = (DM / 64) * (IN_COLS / 64), I_OUT = (DM / 64) * (DM / 64), I_G = (DM / 64) * (DFF / 64), I_D = (DFF / 64) * (DM / 64);
    constexpr int I_LAYER = I_IN + I_OUT + 2 * I_G + I_D;
    for (int it = gw; it < DEPTH * I_LAYER; it += NGW) {
        const int l = it / I_LAYER; int r = it - l * I_LAYER;
        if (r < I_IN) { p0_item(a.w_in + (size_t)l * DM * IN_COLS, DM, IN_COLS, (bf16*)(a.ws + WS_WIN + l * SZ_WIN), a.attn_norm + l * DM, 0, scr, r, lane); continue; } r -= I_IN;
        if (r < I_OUT) { p0_item(a.w_out + (size_t)l * DM * DM, DM, DM, (bf16*)(a.ws + WS_WOUT + l * SZ_WOUT), nullptr, 0, scr, r, lane); continue; } r -= I_OUT;
        if (r < I_G) { p0_item(a.w_gate + (size_t)l * DM * DFF, DM, DFF, (bf16*)(a.ws + WS_WGU + l * SZ_WGU), a.ffn_norm + l * DM, 1, scr, r, lane); continue; } r -= I_G;
        if (r < I_G) { p0_item(a.w_up + (size_t)l * DM * DFF, DM, DFF, (bf16*)(a.ws + WS_WGU + l * SZ_WGU), a.ffn_norm + l * DM, 2, scr, r, lane); continue; } r -= I_G;
        p0_item(a.w_down + (size_t)l * DFF * DM, DFF, DM, (bf16*)(a.ws + WS_WDN + l * SZ_WDN), nullptr, 0, scr, r, lane);
    }
    bf16* xb = (bf16*)(a.ws + WS_XB); float* ssq = (float*)(a.ws + WS_SSQ);
    for (int m = gw; m < T; m += NGW) {
        const f32x4* xr = (const f32x4*)(a.x + (size_t)m * DM) + lane; f32x4 v[8]; float ss = 0.f;
#pragma unroll
        for (int j = 0; j < 8; ++j) { v[j] = xr[64 * j]; ss += dot4(v[j]); }
        ss = wave_sum(ss);
        f32x4* orow = (f32x4*)(a.out + (size_t)m * DM) + lane; v2u* brow = (v2u*)(xb + (size_t)m * DM) + lane;
#pragma unroll
        for (int j = 0; j < 8; ++j) { orow[64 * j] = v[j]; v2u w; w.x = pkbf(v[j][0], v[j][1]); w.y = pkbf(v[j][2], v[j][3]); brow[64 * j] = w; }
        if (lane < 32) ssq[(size_t)m * 32 + lane] = (lane == 0) ? ss : 0.f;
    }
}

constexpr int KV_PITCH = 144, KV_ROWS = 272, LDS_KOFF = 0, LDS_VOFF = KV_ROWS * KV_PITCH;
constexpr int N_UNITS_A = 3 * 1024, N_UNITS = N_UNITS_A + 1024;
__device__ __forceinline__ v4i16_t vtr(const LAS unsigned char* p) { return __builtin_amdgcn_ds_read_tr16_b64_v4i16((LAS v4i16_t*)p); }

__device__ __forceinline__ void attn_unit(LAS unsigned char* lds, const bf16* __restrict__ proj, int idx, const float* sinks_l,
                                          bf16* oA, bf16* oB, float* mA, float* lA, int tid, int wave, int lane) {
    int d, b, r, qt, qcol, kcol, vcol, br, hh; float slope, maxd, sink_l2 = 0.f;
    if (idx < N_UNITS_A) {
        br = idx >> 10; const int rem = idx & 1023; d = (br == 0) ? 1 : (br == 1 ? 4 : 16);
        b = rem >> 8; hh = (rem >> 4) & 15; const int nqt = 16 / d, w16 = rem & 15; r = w16 / nqt; qt = w16 - r * nqt;
        qcol = C_QA + hh * 64; kcol = C_KA + hh * 64; vcol = C_VA + hh * 64;
        slope = __builtin_amdgcn_exp2f(-(float)(2 * hh + 1) * 0.25f); maxd = 128.f;
    } else {
        br = 3; const int rem = idx - N_UNITS_A; d = 1; r = 0;
        b = rem >> 8; const int g = (rem >> 7) & 1, rr = (rem >> 4) & 7; qt = rem & 15; hh = g * 8 + rr;
        qcol = C_QB + hh * 64; kcol = C_KB + g * 64; vcol = C_VB + g * 64;
        slope = __builtin_amdgcn_exp2f(-(float)(hh + 1) * 0.5f); maxd = 127.f;
        sink_l2 = sinks_l[hh] * LOG2E;
    }
    const float sl2 = slope * (float)d * LOG2E;
    const float C2 = 0.125f * LOG2E;
    const int fr = lane & 15, fq = lane >> 4;
    {
        const int c8 = tid & 7, r0 = tid >> 3;
#pragma unroll
        for (int i = 0; i < 4; ++i) {
            const int row = r0 + 64 * i, ks = 128 * qt - 128 + row;
            v4u kv = {0u, 0u, 0u, 0u}, vv = {0u, 0u, 0u, 0u};
            if (ks >= 0) { const bf16* p = proj + (size_t)(b * SEQ + r + d * ks) * IN_COLS + 8 * c8; kv = *(const v4u*)(p + kcol); vv = *(const v4u*)(p + vcol); }
            *(LAS v4u*)(lds + LDS_KOFF + row * KV_PITCH + 16 * c8) = kv;
            *(LAS v4u*)(lds + LDS_VOFF + row * KV_PITCH + 16 * c8) = vv;
        }
        if (tid < 128) { const int row = 256 + (tid >> 3); const v4u z = {0u, 0u, 0u, 0u};
            *(LAS v4u*)(lds + LDS_KOFF + row * KV_PITCH + 16 * c8) = z; *(LAS v4u*)(lds + LDS_VOFF + row * KV_PITCH + 16 * c8) = z; }
    }
    const int iq = 128 * qt + 16 * wave + fr;
    const size_t grow = (size_t)(b * SEQ + r + d * iq);
    const bf16* qp = proj + grow * IN_COLS + qcol + 8 * fq;
    const bf16x8 q0 = *(const bf16x8*)qp, q1 = *(const bf16x8*)(qp + 32);
    __syncthreads();
    f32x4 sc[9];
    {
        const LAS unsigned char* kb = lds + LDS_KOFF + (16 * wave + fr) * KV_PITCH + 16 * fq;
#pragma unroll
        for (int j = 0; j < 9; ++j) {
            const bf16x8 k0 = *(const LAS bf16x8*)(kb + j * 16 * KV_PITCH), k1 = *(const LAS bf16x8*)(kb + j * 16 * KV_PITCH + 64);
            f32x4 z = {0.f, 0.f, 0.f, 0.f};
            z = __builtin_amdgcn_mfma_f32_16x16x32_bf16(k0, q0, z, 0, 0, 0);
            sc[j] = __builtin_amdgcn_mfma_f32_16x16x32_bf16(k1, q1, z, 0, 0, 0);
        }
    }
    const float bl = (float)(fr - 4 * fq);
    const bool early = (qt == 0);
    float mx = -INFINITY;
#pragma unroll
    for (int j = 0; j < 9; ++j)
#pragma unroll
        for (int jj = 0; jj < 4; ++jj) {
            const float dist = (float)(128 - 16 * j - jj) + bl;
            float v = __builtin_fmaf(sc[j][jj], C2, -sl2 * dist);
            bool ok = true;
            if (j == 0) ok = dist <= maxd;
            if (j == 8) ok = dist >= 0.f;
            if (early && (wave + j < 8)) ok = false;
            v = ok ? v : -INFINITY; sc[j][jj] = v; mx = __builtin_fmaxf(mx, v);
        }
    mx = __builtin_fmaxf(mx, __shfl_xor(mx, 16)); mx = __builtin_fmaxf(mx, __shfl_xor(mx, 32));
    float lsum = 0.f;
#pragma unroll
    for (int j = 0; j < 9; ++j)
#pragma unroll
        for (int jj = 0; jj < 4; ++jj) { const float p = __builtin_amdgcn_exp2f(sc[j][jj] - mx); sc[j][jj] = p; lsum += p; }
    lsum += __shfl_xor(lsum, 16); lsum += __shfl_xor(lsum, 32);
    f32x4 o[4];
#pragma unroll
    for (int dt = 0; dt < 4; ++dt) o[dt] = (f32x4){0.f, 0.f, 0.f, 0.f};
    {
        const int q4 = (lane & 15) >> 2, p4 = lane & 3;
        const LAS unsigned char* vb = lds + LDS_VOFF + (16 * wave + 4 * fq + q4) * KV_PITCH + 8 * p4;
#pragma unroll
        for (int c = 0; c < 5; ++c) {
            v4u yw; yw.x = pkbf(sc[2 * c][0], sc[2 * c][1]); yw.y = pkbf(sc[2 * c][2], sc[2 * c][3]);
            if (c < 4) { yw.z = pkbf(sc[(c < 4) ? 2 * c + 1 : 0][0], sc[(c < 4) ? 2 * c + 1 : 0][1]); yw.w = pkbf(sc[(c < 4) ? 2 * c + 1 : 0][2], sc[(c < 4) ? 2 * c + 1 : 0][3]); }
            else { yw.z = 0u; yw.w = 0u; }
            const bf16x8 Y = __builtin_bit_cast(bf16x8, yw);
#pragma unroll
            for (int dt = 0; dt < 4; ++dt) {
                const v4i16_t lo = vtr(vb + (32 * c) * KV_PITCH + 32 * dt), hi = vtr(vb + (32 * c + 16) * KV_PITCH + 32 * dt);
                const bf16x8 X = {lo[0], lo[1], lo[2], lo[3], hi[0], hi[1], hi[2], hi[3]};
                o[dt] = __builtin_amdgcn_mfma_f32_16x16x32_bf16(X, Y, o[dt], 0, 0, 0);
            }
        }
    }
    float inv; bf16* op;
    if (br < 3) {
        inv = __builtin_amdgcn_rcpf(lsum);
        if (fq == 0) { mA[((size_t)br * T + grow) * 16 + hh] = mx; lA[((size_t)br * T + grow) * 16 + hh] = lsum; }
        op = oA + ((size_t)br * T + grow) * 1024 + hh * 64 + 4 * fq;
    } else {
        const float m2 = __builtin_fmaxf(mx, sink_l2), cf = __builtin_amdgcn_exp2f(mx - m2);
        inv = cf * __builtin_amdgcn_rcpf(lsum * cf + __builtin_amdgcn_exp2f(sink_l2 - m2));
        op = oB + grow * 1024 + hh * 64 + 4 * fq;
    }
#pragma unroll
    for (int dt = 0; dt < 4; ++dt) { v2u w; w.x = pkbf(o[dt][0] * inv, o[dt][1] * inv); w.y = pkbf(o[dt][2] * inv, o[dt][3] * inv); *(v2u*)(op + 16 * dt) = w; }
    __syncthreads();
}

__device__ __forceinline__ void merge_phase(const Args& a, int layer, int wave, int lane) {
    const bf16* oA = (const bf16*)(a.ws + WS_OA); const bf16* oB = (const bf16*)(a.ws + WS_OB);
    const float* mA = (const float*)(a.ws + WS_MA); const float* lA = (const float*)(a.ws + WS_LA);
    bf16* mix = (bf16*)(a.ws + WS_MIX);
    const float* gA = a.out_norm_a + layer * 1024 + lane * 16; const float* gB = a.out_norm_b + layer * 1024 + lane * 16;
    const int gw = blockIdx.x * NWAVES + wave, NGW = gridDim.x * NWAVES, ha = lane >> 2;
    for (int t = gw; t < T; t += NGW) {
        float wgt[3]; float mxx = -INFINITY;
#pragma unroll
        for (int i = 0; i < 3; ++i) { wgt[i] = mA[((size_t)i * T + t) * 16 + ha]; mxx = __builtin_fmaxf(mxx, wgt[i]); }
        float wsum = 0.f;
#pragma unroll
        for (int i = 0; i < 3; ++i) { wgt[i] = __builtin_amdgcn_exp2f(wgt[i] - mxx) * lA[((size_t)i * T + t) * 16 + ha]; wsum += wgt[i]; }
        const float winv = 1.0f / wsum;
        float acc[16];
#pragma unroll
        for (int k = 0; k < 16; ++k) acc[k] = 0.f;
#pragma unroll
        for (int i = 0; i < 3; ++i) {
            const v4u* p = (const v4u*)(oA + ((size_t)i * T + t) * 1024 + lane * 16); const float wi = wgt[i] * winv;
#pragma unroll
            for (int h2 = 0; h2 < 2; ++h2) { const v4u q = p[h2];
#pragma unroll
                for (int k = 0; k < 4; ++k) { acc[h2 * 8 + 2 * k] += wi * __uint_as_float(q[k] << 16); acc[h2 * 8 + 2 * k + 1] += wi * __uint_as_float(q[k] & 0xffff0000u); } }
        }
        float ss = 0.f;
#pragma unroll
        for (int k = 0; k < 16; ++k) ss += acc[k] * acc[k];
        ss = wave_sum(ss);
        float rs = __builtin_amdgcn_rsqf(ss * (1.0f / 1024.f) + EPS);
        {
            v4u o0, o1; const f32x4 g0 = *(const f32x4*)(gA), g1 = *(const f32x4*)(gA + 4), g2 = *(const f32x4*)(gA + 8), g3 = *(const f32x4*)(gA + 12);
            o0.x = pkbf(acc[0] * rs * g0[0], acc[1] * rs * g0[1]); o0.y = pkbf(acc[2] * rs * g0[2], acc[3] * rs * g0[3]);
            o0.z = pkbf(acc[4] * rs * g1[0], acc[5] * rs * g1[1]); o0.w = pkbf(acc[6] * rs * g1[2], acc[7] * rs * g1[3]);
            o1.x = pkbf(acc[8] * rs * g2[0], acc[9] * rs * g2[1]); o1.y = pkbf(acc[10] * rs * g2[2], acc[11] * rs * g2[3]);
            o1.z = pkbf(acc[12] * rs * g3[0], acc[13] * rs * g3[1]); o1.w = pkbf(acc[14] * rs * g3[2], acc[15] * rs * g3[3]);
            v4u* mp = (v4u*)(mix + (size_t)t * DM + lane * 16); mp[0] = o0; mp[1] = o1;
        }
        {
            const v4u* p = (const v4u*)(oB + (size_t)t * 1024 + lane * 16);
#pragma unroll
            for (int h2 = 0; h2 < 2; ++h2) { const v4u q = p[h2];
#pragma unroll
                for (int k = 0; k < 4; ++k) { acc[h2 * 8 + 2 * k] = __uint_as_float(q[k] << 16); acc[h2 * 8 + 2 * k + 1] = __uint_as_float(q[k] & 0xffff0000u); } }
            ss = 0.f;
#pragma unroll
            for (int k = 0; k < 16; ++k) ss += acc[k] * acc[k];
            ss = wave_sum(ss);
            rs = __builtin_amdgcn_rsqf(ss * (1.0f / 1024.f) + EPS);
            v4u o0, o1; const f32x4 g0 = *(const f32x4*)(gB), g1 = *(const f32x4*)(gB + 4), g2 = *(const f32x4*)(gB + 8), g3 = *(const f32x4*)(gB + 12);
            o0.x = pkbf(acc[0] * rs * g0[0], acc[1] * rs * g0[1]); o0.y = pkbf(acc[2] * rs * g0[2], acc[3] * rs * g0[3]);
            o0.z = pkbf(acc[4] * rs * g1[0], acc[5] * rs * g1[1]); o0.w = pkbf(acc[6] * rs * g1[2], acc[7] * rs * g1[3]);
            o1.x = pkbf(acc[8] * rs * g2[0], acc[9] * rs * g2[1]); o1.y = pkbf(acc[10] * rs * g2[2], acc[11] * rs * g2[3]);
            o1.z = pkbf(acc[12] * rs * g3[0], acc[13] * rs * g3[1]); o1.w = pkbf(acc[14] * rs * g3[2], acc[15] * rs * g3[3]);
            v4u* mp = (v4u*)(mix + (size_t)t * DM + 1024 + lane * 16); mp[0] = o0; mp[1] = o1;
        }
    }
}

__device__ __forceinline__ void final_phase(const Args& a, int wave, int lane) {
    const int gw = blockIdx.x * NWAVES + wave, NGW = gridDim.x * NWAVES;
    for (int m = gw; m < T; m += NGW) {
        f32x4* xr = (f32x4*)(a.out + (size_t)m * DM) + lane; const f32x4* gr = (const f32x4*)a.final_norm + lane; f32x4 v[8]; float ss = 0.f;
#pragma unroll
        for (int j = 0; j < 8; ++j) { v[j] = xr[64 * j]; ss += dot4(v[j]); }
        ss = wave_sum(ss);
        const float rs = __builtin_amdgcn_rsqf(ss * (1.0f / DM) + EPS);
#pragma unroll
        for (int j = 0; j < 8; ++j) xr[64 * j] = v[j] * rs * gr[64 * j];
    }
}


#define RLX_AGENT __ATOMIC_RELAXED, __HIP_MEMORY_SCOPE_AGENT
#define XB_TMO      128
#define XB_XCNT(j)  (256  + 64 * (j))
#define XB_XSUB(j)  (1280 + 64 * (j))
#define XB_XGEN(j)  (2304 + 64 * (j))
#define XB_TOP      3328
#define XB_TOPGEN   3392
#define XCD_BAR_WORDS 3456
#define XB_SPIN_CAP (1u << 18)

__device__ __forceinline__ unsigned xb_ld(unsigned* p)              { return __hip_atomic_load(p, __ATOMIC_RELAXED, __HIP_MEMORY_SCOPE_AGENT); }
__device__ __forceinline__ unsigned xb_add(unsigned* p, unsigned v) { return __hip_atomic_fetch_add(p, v, __ATOMIC_RELAXED, __HIP_MEMORY_SCOPE_AGENT); }
__device__ __forceinline__ unsigned xb_xcc_id() { return (unsigned)__builtin_amdgcn_s_getreg((3 << 11) | 20) & 0xFu; }
#define XB_SPIN(cond, bar) do { unsigned _sp = 0; while (cond) { __builtin_amdgcn_s_sleep(1); \
    if ((++_sp & 255u) == 0u) { if (xb_ld(&(bar)[XB_TMO])) break; if (_sp > XB_SPIN_CAP) { atomicAdd(&(bar)[XB_TMO], 1u); break; } } } } while (0)

struct XcdBarrier {
    unsigned* bar; unsigned x;
    volatile LAS unsigned* st;
};

__device__ __forceinline__ XcdBarrier xcd_barrier_post(unsigned* bar, volatile LAS unsigned* st) {
    XcdBarrier b; b.bar = bar; b.x = xb_xcc_id(); b.st = st;
    if (threadIdx.x == 0) (void)xb_add(&bar[XB_XCNT(b.x)], 1u);
    return b;
}
__device__ __forceinline__ void xcd_barrier_complete(unsigned* bar, unsigned x, unsigned& nloc, unsigned& nx) {
    const unsigned G = gridDim.x * gridDim.y * gridDim.z;
    unsigned sum, cnt, mine, sp = 0u;
    for (;;) {
        sum = 0u; cnt = 0u; mine = 0u;
#pragma unroll
        for (unsigned j = 0; j < 16; ++j) { const unsigned c = xb_ld(&bar[XB_XCNT(j)]); sum += c; cnt += (c > 0u) ? 1u : 0u; mine = (j == x) ? c : mine; }
        if (sum == G) break;
        __builtin_amdgcn_s_sleep(1);
        if ((++sp & 255u) == 0u) { if (xb_ld(&bar[XB_TMO])) break; if (sp > XB_SPIN_CAP) { atomicAdd(&bar[XB_TMO], 1u); break; } }
    }
    nloc = mine > 0u ? mine : 1u; nx = cnt > 0u ? cnt : 1u;
}

__device__ __forceinline__ void xcd_barrier(const XcdBarrier& b) {
    asm volatile("s_waitcnt vmcnt(0)" ::: "memory");
    __syncthreads();
    if (threadIdx.x == 0) {
        unsigned* bar = b.bar;
        __builtin_amdgcn_s_waitcnt(0);
        unsigned nloc = b.st[0], nx = b.st[1];
        if (nloc == 0u) { xcd_barrier_complete(bar, b.x, nloc, nx); b.st[0] = nloc; b.st[1] = nx; }
        const unsigned old = xb_add(&bar[XB_XSUB(b.x)], 1u);
        const unsigned gen = old / nloc;
        if (old + 1u == (gen + 1u) * nloc) {
            __builtin_amdgcn_fence(__ATOMIC_RELEASE, "agent");
            asm volatile("s_waitcnt vmcnt(0)" ::: "memory");
            const unsigned og = xb_add(&bar[XB_TOP], 1u);
            const unsigned tg = og / nx;
            if (og + 1u == (tg + 1u) * nx) xb_add(&bar[XB_TOPGEN], 1u);
            else XB_SPIN(xb_ld(&bar[XB_TOPGEN]) == tg, bar);
            __builtin_amdgcn_fence(__ATOMIC_ACQUIRE, "agent");
            xb_add(&bar[XB_XGEN(b.x)], 1u);
            asm volatile("s_waitcnt vmcnt(0)" ::: "memory");
        } else {
            XB_SPIN(xb_ld(&bar[XB_XGEN(b.x)]) == gen, bar);
            __builtin_amdgcn_fence(__ATOMIC_ACQUIRE, "agent");
            asm volatile("s_waitcnt vmcnt(0)" ::: "memory");
        }
    }
    __syncthreads();
}

#ifndef PROBE_DUP
#define PROBE_DUP -1
#endif
#ifndef PROBE_P0
#define PROBE_P0 0
#endif
constexpr int PL = 6 + (PROBE_DUP >= 0 ? 1 : 0), PH0 = 1 + PROBE_P0;
constexpr int N_PHASES = PH0 + 1 + PL * DEPTH;
__global__ void __launch_bounds__(NTHREADS, 2) fwd_megakernel(Args a) {
    extern __shared__ __attribute__((aligned(16))) unsigned char lds_raw[];
    cg::grid_group grid = cg::this_grid();
    LAS unsigned char* lds = (LAS unsigned char*)lds_raw;
    bf16* xb = (bf16*)(a.ws + WS_XB); bf16* proj = (bf16*)(a.ws + WS_PROJ); bf16* mix = (bf16*)(a.ws + WS_MIX); bf16* act = (bf16*)(a.ws + WS_ACT);
    float* ssq = (float*)(a.ws + WS_SSQ);
    volatile LAS unsigned* MISC = (volatile LAS unsigned*)(lds + MISC_OFF);
    if (threadIdx.x < 32) MISC[threadIdx.x] = 0u;
    __syncthreads();
    XcdBarrier bar = xcd_barrier_post((unsigned*)(a.ws + WS_BAR), MISC + 8);
    for (int ph = a.ph_lo; ph < a.ph_hi; ++ph) {
        int tid_l = threadIdx.x; asm volatile("" : "+v"(tid_l));
        const int tid = tid_l, lane = tid & 63, wave = __builtin_amdgcn_readfirstlane(tid >> 6);
        if (ph < PH0) p0_phase(a, lds, wave, lane);
        else if (ph == N_PHASES - 1) final_phase(a, wave, lane);
        else {
            const int l = (ph - PH0) / PL, kq = (ph - PH0) - PL * l, k = (PROBE_DUP >= 0 && kq > PROBE_DUP) ? kq - 1 : kq;
            if (k == 0) {
                pg8::Gemm g{xb, (const bf16*)(a.ws + WS_WIN + l * SZ_WIN), T, IN_COLS, DM}; pg8::StaticOrder S; S.init(T, IN_COLS, (int)gridDim.x, (int)blockIdx.x);
                EpiScaleBf16 E{proj, IN_COLS, ssq};
                pg8::gemm_phase<EpiScaleBf16, pg8::StaticOrder, true, true>(lds, g, S, E);
            } else if (k == 1) {
                for (int idx = blockIdx.x; idx < N_UNITS; idx += gridDim.x)
                    attn_unit(lds, proj, idx, a.sinks + l * 16, (bf16*)(a.ws + WS_OA), (bf16*)(a.ws + WS_OB), (float*)(a.ws + WS_MA), (float*)(a.ws + WS_LA), tid, wave, lane);
            } else if (k == 2) {
                merge_phase(a, l, wave, lane);
            } else if (k == 3) {
                pg8::Gemm g{mix, (const bf16*)(a.ws + WS_WOUT + l * SZ_WOUT), T, DM, DM}; pg8::StaticOrder S; S.init(T, DM, (int)gridDim.x, (int)blockIdx.x);
                EpiResid E{a.out, xb, ssq};
                pg8::gemm_phase<EpiResid, pg8::StaticOrder, false, true>(lds, g, S, E);
            } else if (k == 4) {
                pg8::Gemm g{xb, (const bf16*)(a.ws + WS_WGU + l * SZ_WGU), T, NGU, DM}; pg8::StaticOrder S; S.init(T, NGU, (int)gridDim.x, (int)blockIdx.x);
                EpiSwiglu E{act, ssq};
                pg8::gemm_phase<EpiSwiglu, pg8::StaticOrder, true, true>(lds, g, S, E);
            } else {
                pg8::Gemm g{act, (const bf16*)(a.ws + WS_WDN + l * SZ_WDN), T, DM, DFF}; pg8::StaticOrder S; S.init(T, DM, (int)gridDim.x, (int)blockIdx.x);
                EpiResid E{a.out, xb, ssq};
                pg8::gemm_phase<EpiResid, pg8::StaticOrder, false, true>(lds, g, S, E);
            }
        }
        if (ph + 1 < a.ph_hi) { if (ph == 0) grid.sync(); else xcd_barrier(bar); }
    }
}

extern "C" void kernel_launch(void* const* d_in, const int* in_sizes, int n_in, void* d_out, int out_size, void* d_ws, size_t ws_size, hipStream_t stream) {
    static int grid = 0;
    if (grid == 0) {
        if (n_in != 12 || in_sizes[0] != T * DM || out_size != T * DM || ws_size < WS_END) { fprintf(stderr, "kernel_launch: unexpected shapes (n_in %d, out %d, ws %zu < %zu)\n", n_in, out_size, ws_size, (size_t)WS_END); grid = -1; return; }
        int dev = 0, cus = 0, per_cu = 0;
        if (hipGetDevice(&dev) != hipSuccess || hipDeviceGetAttribute(&cus, hipDeviceAttributeMultiprocessorCount, dev) != hipSuccess) { grid = -1; return; }
        if (hipFuncSetAttribute((const void*)fwd_megakernel, hipFuncAttributeMaxDynamicSharedMemorySize, LDS_BYTES) != hipSuccess) { fprintf(stderr, "kernel_launch: hipFuncSetAttribute failed\n"); grid = -1; return; }
        if (hipOccupancyMaxActiveBlocksPerMultiprocessor(&per_cu, (const void*)fwd_megakernel, NTHREADS, LDS_BYTES) != hipSuccess || per_cu < 1) per_cu = 1;
        (void)hipGetLastError();
        grid = cus * per_cu;
    }
    if (grid < 0) return;
    if (hipMemsetAsync((unsigned char*)d_ws + WS_BAR, 0, BAR_BYTES, stream) != hipSuccess) { fprintf(stderr, "kernel_launch: memset of the barrier words failed\n"); return; }
    Args a{};
    a.x = (const float*)d_in[0]; a.attn_norm = (const float*)d_in[1]; a.w_in = (const float*)d_in[2]; a.sinks = (const float*)d_in[3];
    a.out_norm_a = (const float*)d_in[4]; a.out_norm_b = (const float*)d_in[5]; a.w_out = (const float*)d_in[6]; a.ffn_norm = (const float*)d_in[7];
    a.w_gate = (const float*)d_in[8]; a.w_up = (const float*)d_in[9]; a.w_down = (const float*)d_in[10]; a.final_norm = (const float*)d_in[11];
    a.out = (float*)d_out; a.ws = (unsigned char*)d_ws; a.ph_lo = 0; a.ph_hi = N_PHASES;
    void* args[] = {&a};
    const hipError_t e = hipLaunchCooperativeKernel((const void*)fwd_megakernel, dim3(grid), dim3(NTHREADS), args, LDS_BYTES, stream);
    if (e != hipSuccess) fprintf(stderr, "kernel_launch: cooperative launch failed: %s (grid %d)\n", hipGetErrorString(e), grid);
}
```

```cpp
#include <hip/hip_runtime.h>
#include <hip/hip_cooperative_groups.h>
#include <cstdio>
#include <cstdint>
namespace cg = cooperative_groups;
namespace pg8 {
#define PG8_LAS __attribute__((address_space(3)))
typedef unsigned short bf16_t;
typedef short bf16x8 __attribute__((ext_vector_type(8)));
typedef float f32x4 __attribute__((ext_vector_type(4)));
typedef unsigned u32x4 __attribute__((ext_vector_type(4)));
constexpr int BM = 256, BK = 64, HALF = 128, HTB = HALF * BK * 2  , STAGE_BYTES = 8 * HTB, NXCD = 8, WGM = 8;

__host__ __device__ __forceinline__ int lds_byte(int r, int c) { const int st = (r >> 4) * 2 + (c >> 5), rr = r & 15, cc = c & 31, ob = rr * 64 + cc * 2; return st * 1024 + (ob ^ (((ob >> 9) & 1) << 5)); }
__host__ __device__ __forceinline__ void stage_rc(int b, int& R, int& C) { const int st = b / 1024, sb = b % 1024, swz = sb ^ (((sb >> 9) & 1) << 5); R = (st >> 1) * 16 + swz / 64; C = (st & 1) * 32 + (swz % 64) / 2; }
__host__ __device__ __forceinline__ int perm32(int rho) { const int n = rho >> 4, i = rho & 15; return 8 * (i >> 2) + 4 * n + (i & 3); }

struct Unit { int pm, pn; };
struct Gemm { const bf16_t* A; const bf16_t* Bt; int M, N, K; };

struct StaticOrder {
    int nM, nN, nwg, G, c;
    __host__ __device__ void init(int M, int N, int G_, int c_) { nM = M / BM; nN = N / BM; nwg = nM * nN; G = G_; c = c_; }
    __host__ __device__ bool next(int i, Unit& u) const {
        const long L = (long)i * G + c; if (L >= nwg) return false;
        int wgid = (int)L; { const int q = nwg / NXCD, r = nwg % NXCD, xcd = wgid % NXCD, off = wgid / NXCD; wgid = (xcd < r ? xcd * (q + 1) : r * (q + 1) + (xcd - r) * q) + off; }
        const int nig = WGM * nN, gid = wgid / nig, fm = gid * WGM, gsz = (nM - fm) < WGM ? (nM - fm) : WGM;
        u.pm = fm + ((wgid % nig) % gsz); u.pn = (wgid % nig) / gsz; return true;
    }
    __device__ __forceinline__ void a_ready(const Unit&) const {}
    __device__ __forceinline__ void done(const Unit&) const {}
};

__device__ __forceinline__ unsigned cvt_pk_bf16(float lo, float hi) { unsigned r; asm volatile("v_cvt_pk_bf16_f32 %0, %1, %2" : "=v"(r) : "v"(lo), "v"(hi)); return r; }
typedef float f32x2 __attribute__((ext_vector_type(2)));
template <class Epi, class Sched, bool ALIGN_EPI = false, bool SP2 = false>
__device__ __forceinline__ void gemm_phase(PG8_LAS unsigned char* lds, const Gemm g, const Sched& S, const Epi& E) {
    int tid_l = threadIdx.x; asm volatile("" : "+v"(tid_l));
    const int tid = tid_l, wid = __builtin_amdgcn_readfirstlane(tid >> 6), lane = tid & 63, wr = wid >> 2, wc = wid & 3, fr = lane & 15, fq = lane >> 4;
    const int K = g.K, nt = K / BK;
    unsigned voffA[2], voffB[2];
#pragma unroll
    for (int i = 0; i < 2; ++i) { int R, C; stage_rc(tid * 16 + i * 8192, R, C); const int Rb = Epi::PERM ? ((R & ~31) + perm32(R & 31)) : R;
        voffA[i] = (unsigned)(R * K + C) * 2u; voffB[i] = (unsigned)(Rb * K + C) * 2u; }
    const size_t kstep = (size_t)(BK * 2);
    const size_t hstep = (size_t)HALF * K * 2;
    const size_t tstep = 2 * hstep;
    const unsigned ldsw = (unsigned)wid * 1024u;
    const int aoff = lds_byte(wr * 64 + fr, fq * 8), boff = lds_byte(wc * 32 + fr, fq * 8);
#define PG8_SA(b, h) (((b) * 2 + (h)) * HTB)
#define PG8_SB(b, h) ((4 + (b) * 2 + (h)) * HTB)
#define PG8_STAGE(bufoff, gbase, voff) do { _Pragma("unroll") for (int _i = 0; _i < 2; ++_i) \
        __builtin_amdgcn_global_load_lds((const unsigned*)((const char*)(gbase) + (voff)[_i]), (PG8_LAS unsigned*)(lds + (bufoff) + ldsw + _i * 8192), 16, 0, 0); } while (0)
#define PG8_LDA(dst, b, h) do { _Pragma("unroll") for (int m = 0; m < 4; ++m) _Pragma("unroll") for (int k = 0; k < 2; ++k) dst[m][k] = *(const PG8_LAS bf16x8*)(lds + PG8_SA(b, h) + aoff + m * 2048 + k * 1024); } while (0)
#define PG8_LDB(dst, b, h) do { _Pragma("unroll") for (int n = 0; n < 2; ++n) _Pragma("unroll") for (int k = 0; k < 2; ++k) dst[n][k] = *(const PG8_LAS bf16x8*)(lds + PG8_SB(b, h) + boff + n * 2048 + k * 1024); } while (0)
#define PG8_MMA(ai, bj, At, Bt) do { __builtin_amdgcn_s_setprio(1); _Pragma("unroll") for (int m = 0; m < 4; ++m) _Pragma("unroll") for (int n = 0; n < 2; ++n) _Pragma("unroll") for (int k = 0; k < 2; ++k) \
        acc[ai][bj][m][n] = __builtin_amdgcn_mfma_f32_16x16x32_bf16(Bt[n][k], At[m][k], acc[ai][bj][m][n], 0, 0, 0); __builtin_amdgcn_s_setprio(0); } while (0)
#define PG8_WAIT_V(n) asm volatile("s_waitcnt vmcnt(" #n ")" ::: "memory")
#define PG8_WAIT_L(n) asm volatile("s_waitcnt lgkmcnt(" #n ")" ::: "memory")
#define PG8_BAR __builtin_amdgcn_s_barrier()
#define PG8_SCHED __builtin_amdgcn_sched_barrier(0)
    Unit cur, nxt; int ui = 0;
    if (!S.next(0, cur)) return;
    f32x4 acc[2][2][4][2];
#pragma unroll
    for (int a = 0; a < 2; ++a)
#pragma unroll
        for (int b = 0; b < 2; ++b)
#pragma unroll
            for (int m = 0; m < 4; ++m)
#pragma unroll
                for (int n = 0; n < 2; ++n) acc[a][b][m][n] = (f32x4){0.f, 0.f, 0.f, 0.f};
    bf16x8 At[4][2], B0[2][2], B1[2][2];
    const char* cA = (const char*)g.A + (size_t)cur.pm * tstep; const char* cB = (const char*)g.Bt + (size_t)cur.pn * tstep;
    S.a_ready(cur);
    if constexpr (SP2) {
        PG8_STAGE(PG8_SB(0, 0), cB, voffB); PG8_STAGE(PG8_SB(0, 1), cB + hstep, voffB); PG8_STAGE(PG8_SA(0, 0), cA, voffA); PG8_STAGE(PG8_SA(0, 1), cA + hstep, voffA);
        if (wr == 1) PG8_BAR;
        PG8_WAIT_V(2); PG8_BAR;
        PG8_STAGE(PG8_SB(1, 0), cB + kstep, voffB); PG8_STAGE(PG8_SA(1, 0), cA + kstep, voffA); PG8_STAGE(PG8_SB(1, 1), cB + hstep + kstep, voffB);
        PG8_WAIT_V(6); PG8_BAR;
    } else {
        PG8_STAGE(PG8_SB(0, 0), cB, voffB); PG8_STAGE(PG8_SA(0, 0), cA, voffA); PG8_STAGE(PG8_SB(0, 1), cB + hstep, voffB); PG8_STAGE(PG8_SA(0, 1), cA + hstep, voffA);
        if (wr == 1) PG8_BAR;
        PG8_WAIT_V(4); PG8_BAR;
        PG8_STAGE(PG8_SB(1, 0), cB + kstep, voffB); PG8_STAGE(PG8_SA(1, 0), cA + kstep, voffA); PG8_STAGE(PG8_SB(1, 1), cB + hstep + kstep, voffB);
        PG8_WAIT_V(6); PG8_BAR;
    }
    for (;;) {
        const bool has_next = S.next(ui + 1, nxt);
        const char* nA = has_next ? (const char*)g.A + (size_t)nxt.pm * tstep : cA; const char* nB = has_next ? (const char*)g.Bt + (size_t)nxt.pn * tstep : cB;
        for (int t = 0; t < nt; t += 2) {
            const bool last = (t == nt - 2);
            const char* a1 = cA + (size_t)(t + 1) * kstep;
            const char* a2 = last ? nA : cA + (size_t)(t + 2) * kstep; const char* b2 = last ? nB : cB + (size_t)(t + 2) * kstep;
            const char* a3 = a2 + kstep; const char* b3 = b2 + kstep;
            if (last && has_next) S.a_ready(nxt);
            if constexpr (SP2) {
            PG8_LDB(B0, 0, 0); PG8_LDB(B1, 0, 1); PG8_SCHED; PG8_LDA(At, 0, 0); PG8_STAGE(PG8_SA(1, 1), a1 + hstep, voffA);
            PG8_WAIT_V(8); PG8_WAIT_L(0); PG8_BAR; PG8_MMA(0, 0, At, B0); PG8_MMA(0, 1, At, B1); PG8_BAR; PG8_SCHED;
            PG8_LDA(At, 0, 1); PG8_STAGE(PG8_SB(0, 0), b2, voffB); PG8_STAGE(PG8_SB(0, 1), b2 + hstep, voffB); PG8_STAGE(PG8_SA(0, 0), a2, voffA);
            PG8_WAIT_V(8); PG8_WAIT_L(0); PG8_BAR; PG8_MMA(1, 0, At, B0); PG8_MMA(1, 1, At, B1); PG8_BAR; PG8_SCHED;
            PG8_LDB(B0, 1, 0); PG8_LDB(B1, 1, 1); PG8_SCHED; PG8_LDA(At, 1, 0); PG8_STAGE(PG8_SA(0, 1), a2 + hstep, voffA);
            PG8_WAIT_V(8); PG8_WAIT_L(0); PG8_BAR; PG8_MMA(0, 0, At, B0); PG8_MMA(0, 1, At, B1); PG8_BAR; PG8_SCHED;
            PG8_LDA(At, 1, 1); PG8_STAGE(PG8_SB(1, 0), b3, voffB); PG8_STAGE(PG8_SB(1, 1), b3 + hstep, voffB); PG8_STAGE(PG8_SA(1, 0), a3, voffA);
            PG8_WAIT_V(8); PG8_WAIT_L(0); PG8_BAR; PG8_MMA(1, 0, At, B0); PG8_MMA(1, 1, At, B1); PG8_BAR; PG8_SCHED;
            } else {
            PG8_LDB(B0, 0, 0); PG8_SCHED; PG8_LDA(At, 0, 0); PG8_STAGE(PG8_SA(1, 1), a1 + hstep, voffA);
            PG8_WAIT_L(8); PG8_BAR; PG8_WAIT_L(0); PG8_MMA(0, 0, At, B0); PG8_BAR; PG8_SCHED;
            PG8_LDB(B1, 0, 1); PG8_STAGE(PG8_SB(0, 0), b2, voffB);
            PG8_BAR; PG8_WAIT_L(0); PG8_MMA(0, 1, At, B1); PG8_BAR;
            PG8_LDA(At, 0, 1); PG8_STAGE(PG8_SA(0, 0), a2, voffA);
            PG8_BAR; PG8_WAIT_L(0); PG8_MMA(1, 0, At, B0); PG8_BAR; PG8_SCHED;
            PG8_STAGE(PG8_SB(0, 1), b2 + hstep, voffB);
            PG8_WAIT_V(6); PG8_BAR; PG8_MMA(1, 1, At, B1); PG8_BAR;
            PG8_LDB(B0, 1, 0); PG8_SCHED; PG8_LDA(At, 1, 0); PG8_STAGE(PG8_SA(0, 1), a2 + hstep, voffA);
            PG8_WAIT_L(8); PG8_BAR; PG8_WAIT_L(0); PG8_MMA(0, 0, At, B0); PG8_BAR; PG8_SCHED;
            PG8_LDB(B1, 1, 1); PG8_STAGE(PG8_SB(1, 0), b3, voffB);
            PG8_BAR; PG8_WAIT_L(0); PG8_MMA(0, 1, At, B1); PG8_BAR;
            PG8_LDA(At, 1, 1); PG8_STAGE(PG8_SA(1, 0), a3, voffA);
            PG8_BAR; PG8_WAIT_L(0); PG8_MMA(1, 0, At, B0); PG8_BAR; PG8_SCHED;
            PG8_STAGE(PG8_SB(1, 1), b3 + hstep, voffB);
            PG8_WAIT_V(6); PG8_BAR; PG8_MMA(1, 1, At, B1); PG8_BAR;
            }
        }
        if constexpr (ALIGN_EPI) { if (wr == 0) PG8_BAR; }
        if constexpr (!Epi::AFTER_DRAIN) { E(acc, cur, wr, wc, fr, fq); S.done(cur); }
        if (!has_next) break;
#pragma unroll
        for (int a = 0; a < 2; ++a)
#pragma unroll
            for (int b = 0; b < 2; ++b)
#pragma unroll
                for (int m = 0; m < 4; ++m)
#pragma unroll
                    for (int n = 0; n < 2; ++n) acc[a][b][m][n] = (f32x4){0.f, 0.f, 0.f, 0.f};
        cur = nxt; cA = nA; cB = nB; ++ui;
        if constexpr (ALIGN_EPI) { if (wr == 1) PG8_BAR; }
    }
    PG8_WAIT_V(0);
    if constexpr (!ALIGN_EPI) { if (wr == 0) PG8_BAR; }
    PG8_BAR;
    if constexpr (Epi::AFTER_DRAIN) { E.fused(acc, cur, wr, wc, fr, fq, lds, wid, lane); S.done(cur); }
#undef PG8_SA
#undef PG8_SB
#undef PG8_STAGE
#undef PG8_LDA
#undef PG8_LDB
#undef PG8_MMA
#undef PG8_WAIT_V
#undef PG8_WAIT_L
#undef PG8_BAR
#undef PG8_SCHED
}
}

#define LAS __attribute__((address_space(3)))
typedef unsigned short bf16;
typedef unsigned v4u __attribute__((ext_vector_type(4)));
typedef unsigned v2u __attribute__((ext_vector_type(2)));
typedef float f32x4 __attribute__((ext_vector_type(4)));
typedef short bf16x8 __attribute__((ext_vector_type(8)));
typedef short v4i16_t __attribute__((ext_vector_type(4)));

constexpr int BATCH = 4, SEQ = 2048, DM = 2048, DEPTH = 4;
constexpr int T = BATCH * SEQ;
constexpr int IN_COLS = 4352, DFF = 5632, NGU = 2 * DFF;
constexpr int C_QA = 0, C_KA = 1024, C_VA = 2048, C_QB = 3072, C_KB = 4096, C_VB = 4224;
constexpr float EPS = 1e-6f, LOG2E = 1.4426950408889634f;
constexpr int NWAVES = 8, NTHREADS = 512;
constexpr int LDS_BYTES = 136 * 1024;

constexpr size_t SZ_WIN = (size_t)IN_COLS * DM * 2, SZ_WOUT = (size_t)DM * DM * 2, SZ_WGU = (size_t)NGU * DM * 2, SZ_WDN = (size_t)DM * DFF * 2;
constexpr size_t WS_WIN = 0;
constexpr size_t WS_WOUT = WS_WIN + DEPTH * SZ_WIN;
constexpr size_t WS_WGU = WS_WOUT + DEPTH * SZ_WOUT;
constexpr size_t WS_WDN = WS_WGU + DEPTH * SZ_WGU;
constexpr size_t WS_XB = WS_WDN + DEPTH * SZ_WDN;
constexpr size_t WS_PROJ = WS_XB + (size_t)T * DM * 2;
constexpr size_t WS_OA = WS_PROJ + (size_t)T * IN_COLS * 2;
constexpr size_t WS_OB = WS_OA + 3 * (size_t)T * 1024 * 2;
constexpr size_t WS_MIX = WS_OB + (size_t)T * 1024 * 2;
constexpr size_t WS_ACT = WS_MIX + (size_t)T * DM * 2;
constexpr size_t WS_SSQ = WS_ACT + (size_t)T * DFF * 2;
constexpr size_t WS_MA = WS_SSQ + (size_t)T * 32 * 4;
constexpr size_t WS_LA = WS_MA + 3 * (size_t)T * 16 * 4;
constexpr size_t WS_BAR = WS_LA + 3 * (size_t)T * 16 * 4;
constexpr size_t BAR_BYTES = 16384;
constexpr size_t WS_END = WS_BAR + BAR_BYTES;
constexpr int MISC_OFF = 135168;

#define LDS_WAIT() asm volatile("s_waitcnt lgkmcnt(0)" ::: "memory")
__device__ __forceinline__ unsigned pkbf(float lo, float hi) { return pg8::cvt_pk_bf16(lo, hi); }
__device__ __forceinline__ float wave_sum(float v) {
#pragma unroll
    for (int o = 1; o < 64; o <<= 1) v += __shfl_xor(v, o);
    return v;
}
__device__ __forceinline__ float dot4(f32x4 v) { return (v[0] * v[0] + v[1] * v[1]) + (v[2] * v[2] + v[3] * v[3]); }

__device__ __forceinline__ void rows_rstd(float (&rs)[2][4], const float* ssq, int row0, int fq) {
    f32x4 pa[2][4], pb[2][4];
#pragma unroll
    for (int ai = 0; ai < 2; ++ai)
#pragma unroll
        for (int m = 0; m < 4; ++m) { const float* p = ssq + (size_t)(row0 + ai * 128 + m * 16) * 32 + 8 * fq; pa[ai][m] = *(const f32x4*)p; pb[ai][m] = *(const f32x4*)(p + 4); }
#pragma unroll
    for (int ai = 0; ai < 2; ++ai)
#pragma unroll
        for (int m = 0; m < 4; ++m) { const f32x4 a = pa[ai][m], b = pb[ai][m];
            float s = ((a[0] + a[1]) + (a[2] + a[3])) + ((b[0] + b[1]) + (b[2] + b[3]));
            s += __shfl_xor(s, 16); s += __shfl_xor(s, 32);
            rs[ai][m] = __builtin_amdgcn_rsqf(s * (1.0f / DM) + EPS); }
}
struct EpiScaleBf16 {
    static constexpr bool PERM = true, AFTER_DRAIN = false;
    bf16* O; int ldc; const float* ssq;
    __device__ __forceinline__ void operator()(const pg8::f32x4 (&acc)[2][2][4][2], const pg8::Unit& u, int wr, int wc, int fr, int fq) const {
        const int row0 = u.pm * 256 + wr * 64 + fr, col0 = u.pn * 256 + wc * 32 + 8 * fq;
        float rs[2][4]; rows_rstd(rs, ssq, row0, fq);
#pragma unroll
        for (int ai = 0; ai < 2; ++ai)
#pragma unroll
            for (int m = 0; m < 4; ++m) {
                const int row = row0 + ai * 128 + m * 16; bf16* rowp = O + (size_t)row * ldc + col0;
#pragma unroll
                for (int bj = 0; bj < 2; ++bj) { const f32x4 v0 = acc[ai][bj][m][0] * rs[ai][m], v1 = acc[ai][bj][m][1] * rs[ai][m];
                    v4u w; w.x = pkbf(v0[0], v0[1]); w.y = pkbf(v0[2], v0[3]); w.z = pkbf(v1[0], v1[1]); w.w = pkbf(v1[2], v1[3]);
                    *(v4u*)(rowp + bj * 128) = w; }
            }
    }
};
struct EpiSwiglu {
    static constexpr bool PERM = true, AFTER_DRAIN = false;
    bf16* O; const float* ssq;
    __device__ __forceinline__ void operator()(const pg8::f32x4 (&acc)[2][2][4][2], const pg8::Unit& u, int wr, int wc, int fr, int fq) const {
        const int row0 = u.pm * 256 + wr * 64 + fr, col0 = u.pn * 128 + wc * 32 + 8 * fq;
        float rs[2][4]; rows_rstd(rs, ssq, row0, fq);
#pragma unroll
        for (int ai = 0; ai < 2; ++ai)
#pragma unroll
            for (int m = 0; m < 4; ++m) {
                const int row = row0 + ai * 128 + m * 16; const float r1 = rs[ai][m];
                float a[8];
#pragma unroll
                for (int n = 0; n < 2; ++n)
#pragma unroll
                    for (int k = 0; k < 4; ++k) { const float g = acc[ai][0][m][n][k] * r1, up = acc[ai][1][m][n][k] * r1;
                        a[n * 4 + k] = g * __builtin_amdgcn_rcpf(1.0f + __builtin_amdgcn_exp2f(-g * LOG2E)) * up; }
                v4u w; w.x = pkbf(a[0], a[1]); w.y = pkbf(a[2], a[3]); w.z = pkbf(a[4], a[5]); w.w = pkbf(a[6], a[7]);
                *(v4u*)(O + (size_t)row * DFF + col0) = w;
            }
    }
};
struct EpiResid {
    static constexpr bool PERM = false, AFTER_DRAIN = false;
    float* x; bf16* xb; float* ssq;
    __device__ __forceinline__ void operator()(const pg8::f32x4 (&acc)[2][2][4][2], const pg8::Unit& u, int wr, int wc, int fr, int fq) const {
        const int row0 = u.pm * 256 + wr * 64 + fr, col0 = u.pn * 256 + wc * 32 + 4 * fq;
#pragma unroll
        for (int ai = 0; ai < 2; ++ai) {
            f32x4 xv[4][2][2];
#pragma unroll
            for (int m = 0; m < 4; ++m) { const float* xr = x + (size_t)(row0 + ai * 128 + m * 16) * DM + col0;
#pragma unroll
                for (int bj = 0; bj < 2; ++bj)
#pragma unroll
                    for (int n = 0; n < 2; ++n) xv[m][bj][n] = *(const f32x4*)(xr + bj * 128 + n * 16); }
#pragma unroll
            for (int m = 0; m < 4; ++m) {
                const int row = row0 + ai * 128 + m * 16; float* xr = x + (size_t)row * DM + col0; bf16* br = xb + (size_t)row * DM + col0; float ss = 0.f;
#pragma unroll
                for (int bj = 0; bj < 2; ++bj)
#pragma unroll
                    for (int n = 0; n < 2; ++n) { const int off = bj * 128 + n * 16; const f32x4 v = xv[m][bj][n] + acc[ai][bj][m][n];
                        *(f32x4*)(xr + off) = v; v2u w; w.x = pkbf(v[0], v[1]); w.y = pkbf(v[2], v[3]); *(v2u*)(br + off) = w; ss += dot4(v); }
                ss += __shfl_xor(ss, 16); ss += __shfl_xor(ss, 32);
                if (fq == 0) ssq[(size_t)row * 32 + u.pn * 4 + wc] = ss;
            }
        }
    }
};

__device__ __forceinline__ void p0_item(const float* __restrict__ W, int K, int N, bf16* WT, const float* g, int mode, LAS float* scr, int item, int lane) {
    const int nblk = N >> 6, kb = item / nblk, nb = item - kb * nblk, k0 = kb << 6, n0 = nb << 6;
    f32x4 v[16];
    const float* src = W + (size_t)(k0 + (lane >> 4)) * N + n0 + 4 * (lane & 15);
#pragma unroll
    for (int i = 0; i < 16; ++i) v[i] = *(const f32x4*)(src + (size_t)(4 * i) * N);
#pragma unroll
    for (int i = 0; i < 16; ++i) { LAS float* d = scr + (4 * i + (lane >> 4)) * 65 + 4 * (lane & 15); d[0] = v[i][0]; d[1] = v[i][1]; d[2] = v[i][2]; d[3] = v[i][3]; }
    LDS_WAIT();
    const int c = lane & 7;
    f32x4 g0 = {1.f, 1.f, 1.f, 1.f}, g1 = {1.f, 1.f, 1.f, 1.f};
    if (g) { g0 = *(const f32x4*)(g + k0 + 8 * c); g1 = *(const f32x4*)(g + k0 + 8 * c + 4); }
#pragma unroll
    for (int j = 0; j < 8; ++j) {
        const int n = (lane >> 3) + 8 * j; const LAS float* s = scr + (8 * c) * 65 + n;
        v4u o; o.x = pkbf(s[0] * g0[0], s[65] * g0[1]); o.y = pkbf(s[130] * g0[2], s[195] * g0[3]); o.z = pkbf(s[260] * g1[0], s[325] * g1[1]); o.w = pkbf(s[390] * g1[2], s[455] * g1[3]);
        const int nn = n0 + n; const int row = (mode == 0) ? nn : (((nn >> 7) << 8) + (nn & 127) + (mode == 2 ? 128 : 0));
        *(v4u*)(WT + (size_t)row * K + k0 + 8 * c) = o;
    }
    LDS_WAIT();
}

struct Args {
    const float* x; const float* attn_norm; const float* w_in; const float* sinks; const float* out_norm_a; const float* out_norm_b;
    const float* w_out; const float* ffn_norm; const float* w_gate; const float* w_up; const float* w_down; const float* final_norm;
    float* out; unsigned char* ws; int ph_lo, ph_hi;
};

__device__ __forceinline__ void p0_phase(const Args& a, LAS unsigned char* lds, int wave, int lane) {
    LAS float* scr = (LAS float*)(lds + wave * 16640);
    const int gw = blockIdx.x * NWAVES + wave, NGW = gridDim.x * NWAVES;
    constexpr int I_IN = (DM / 64) * (IN_COLS / 64), I_OUT = (DM / 64) * (DM / 64), I_G = (DM / 64) * (DFF / 64), I_D = (DFF / 64) * (DM / 64);
    constexpr int I_LAYER = I_IN + I_OUT + 2 * I_G + I_D;
    for (int it = gw; it < DEPTH * I_LAYER; it += NGW) {
        const int l = it / I_LAYER; int r = it - l * I_LAYER;
        if (r < I_IN) { p0_item(a.w_in + (size_t)l * DM * IN_COLS, DM, IN_COLS, (bf16*)(a.ws + WS_WIN + l * SZ_WIN), a.attn_norm + l * DM, 0, scr, r, lane); continue; } r -= I_IN;
        if (r < I_OUT) { p0_item(a.w_out + (size_t)l * DM * DM, DM, DM, (bf16*)(a.ws + WS_WOUT + l * SZ_WOUT), nullptr, 0, scr, r, lane); continue; } r -= I_OUT;
        if (r < I_G) { p0_item(a.w_gate + (size_t)l * DM * DFF, DM, DFF, (bf16*)(a.ws + WS_WGU + l * SZ_WGU), a.ffn_norm + l * DM, 1, scr, r, lane); continue; } r -= I_G;
        if (r < I_G) { p0_item(a.w_up + (size_t)l * DM * DFF, DM, DFF, (bf16*)(a.ws + WS_WGU + l * SZ_WGU), a.ffn_norm + l * DM, 2, scr, r, lane); continue; } r -= I_G;
        p0_item(a.w_down + (size_t)l * DFF * DM, DFF, DM, (bf16*)(a.ws + WS_WDN + l * SZ_WDN), nullptr, 0, scr, r, lane);
    }
    bf16* xb = (bf16*)(a.ws + WS_XB); float* ssq = (float*)(a.ws + WS_SSQ);
    for (int m = gw; m < T; m += NGW) {
        const f32x4* xr = (const f32x4*)(a.x + (size_t)m * DM) + lane; f32x4 v[8]; float ss = 0.f;
#pragma unroll
        for (int j = 0; j < 8; ++j) { v[j] = xr[64 * j]; ss += dot4(v[j]); }
        ss = wave_sum(ss);
        f32x4* orow = (f32x4*)(a.out + (size_t)m * DM) + lane; v2u* brow = (v2u*)(xb + (size_t)m * DM) + lane;
#pragma unroll
        for (int j = 0; j < 8; ++j) { orow[64 * j] = v[j]; v2u w; w.x = pkbf(v[j][0], v[j][1]); w.y = pkbf(v[j][2], v[j][3]); brow[64 * j] = w; }
        if (lane < 32) ssq[(size_t)m * 32 + lane] = (lane == 0) ? ss : 0.f;
    }
}

constexpr int KV_PITCH = 144, KV_ROWS = 272, LDS_KOFF = 0, LDS_VOFF = KV_ROWS * KV_PITCH;
constexpr int N_UNITS_A = 3 * 1024, N_UNITS = N_UNITS_A + 1024;
__device__ __forceinline__ v4i16_t vtr(const LAS unsigned char* p) { return __builtin_amdgcn_ds_read_tr16_b64_v4i16((LAS v4i16_t*)p); }

struct AU { int d, b, r, qt, qcol, kcol, vcol, br, hh; };
__device__ __forceinline__ void au_decode(int idx, AU& u) {
    if (idx < N_UNITS_A) {
        u.br = idx >> 10; const int rem = idx & 1023; u.d = (u.br == 0) ? 1 : (u.br == 1 ? 4 : 16);
        u.b = rem >> 8; u.hh = (rem >> 4) & 15; const int nqt = 16 / u.d, w16 = rem & 15; u.r = w16 / nqt; u.qt = w16 - u.r * nqt;
        u.qcol = C_QA + u.hh * 64; u.kcol = C_KA + u.hh * 64; u.vcol = C_VA + u.hh * 64;
    } else {
        u.br = 3; const int rem = idx - N_UNITS_A; u.d = 1; u.r = 0;
        u.b = rem >> 8; const int g = (rem >> 7) & 1, rr = (rem >> 4) & 7; u.qt = rem & 15; u.hh = g * 8 + rr;
        u.qcol = C_QB + u.hh * 64; u.kcol = C_KB + g * 64; u.vcol = C_VB + g * 64;
    }
}
__device__ __forceinline__ void au_load(const bf16* __restrict__ proj, const float* sinks_l, const AU& u, int tid, int wave, int lane, v4u (&kr)[4], v4u (&vr)[4], bf16x8& q0, bf16x8& q1, float& sink) {
    const int c8 = tid & 7, r0 = tid >> 3;
#pragma unroll
    for (int i = 0; i < 4; ++i) {
        const int row = r0 + 64 * i; int ks = 128 * u.qt - 128 + row; ks = ks < 0 ? 0 : ks;
        const bf16* p = proj + (size_t)(u.b * SEQ + u.r + u.d * ks) * IN_COLS + 8 * c8; kr[i] = *(const v4u*)(p + u.kcol); vr[i] = *(const v4u*)(p + u.vcol);
    }
    const int iq = 128 * u.qt + 16 * wave + (lane & 15);
    const bf16* qp = proj + (size_t)(u.b * SEQ + u.r + u.d * iq) * IN_COLS + u.qcol + 8 * (lane >> 4);
    q0 = *(const bf16x8*)qp; q1 = *(const bf16x8*)(qp + 32);
    sink = sinks_l[u.hh];
}

__device__ __forceinline__ void attn_compute(LAS unsigned char* lds, const AU& u, const bf16x8 q0, const bf16x8 q1, const float sink,
                                             bf16* oA, bf16* oB, float* mA, float* lA, int wave, int lane) {
    const int d = u.d, qt = u.qt, br = u.br, hh = u.hh;
    float slope, maxd, sink_l2 = 0.f;
    if (br < 3) { slope = __builtin_amdgcn_exp2f(-(float)(2 * hh + 1) * 0.25f); maxd = 128.f; }
    else { slope = __builtin_amdgcn_exp2f(-(float)(hh + 1) * 0.5f); maxd = 127.f; sink_l2 = sink * LOG2E; }
    const float sl2 = slope * (float)d * LOG2E;
    const float C2 = 0.125f * LOG2E;
    const int fr = lane & 15, fq = lane >> 4;
    const int iq = 128 * qt + 16 * wave + fr;
    const size_t grow = (size_t)(u.b * SEQ + u.r + d * iq);
    f32x4 sc[9];
    {
        const LAS unsigned char* kb = lds + LDS_KOFF + (16 * wave + fr) * KV_PITCH + 16 * fq;
#pragma unroll
        for (int j = 0; j < 9; ++j) {
            const bf16x8 k0 = *(const LAS bf16x8*)(kb + j * 16 * KV_PITCH), k1 = *(const LAS bf16x8*)(kb + j * 16 * KV_PITCH + 64);
            f32x4 z = {0.f, 0.f, 0.f, 0.f};
            z = __builtin_amdgcn_mfma_f32_16x16x32_bf16(k0, q0, z, 0, 0, 0);
            sc[j] = __builtin_amdgcn_mfma_f32_16x16x32_bf16(k1, q1, z, 0, 0, 0);
        }
    }
    const float bl = (float)(fr - 4 * fq);
    const bool early = (qt == 0);
    float mx = -INFINITY;
#pragma unroll
    for (int j = 0; j < 9; ++j)
#pragma unroll
        for (int jj = 0; jj < 4; ++jj) {
            const float dist = (float)(128 - 16 * j - jj) + bl;
            float v = __builtin_fmaf(sc[j][jj], C2, -sl2 * dist);
            bool ok = true;
            if (j == 0) ok = dist <= maxd;
            if (j == 8) ok = dist >= 0.f;
            if (early && (wave + j < 8)) ok = false;
            v = ok ? v : -INFINITY; sc[j][jj] = v; mx = __builtin_fmaxf(mx, v);
        }
    mx = __builtin_fmaxf(mx, __shfl_xor(mx, 16)); mx = __builtin_fmaxf(mx, __shfl_xor(mx, 32));
    float lsum = 0.f;
#pragma unroll
    for (int j = 0; j < 9; ++j)
#pragma unroll
        for (int jj = 0; jj < 4; ++jj) { const float p = __builtin_amdgcn_exp2f(sc[j][jj] - mx); sc[j][jj] = p; lsum += p; }
    lsum += __shfl_xor(lsum, 16); lsum += __shfl_xor(lsum, 32);
    f32x4 o[4];
#pragma unroll
    for (int dt = 0; dt < 4; ++dt) o[dt] = (f32x4){0.f, 0.f, 0.f, 0.f};
    {
        const int q4 = (lane & 15) >> 2, p4 = lane & 3;
        const LAS unsigned char* vb = lds + LDS_VOFF + (16 * wave + 4 * fq + q4) * KV_PITCH + 8 * p4;
#pragma unroll
        for (int c = 0; c < 5; ++c) {
            v4u yw; yw.x = pkbf(sc[2 * c][0], sc[2 * c][1]); yw.y = pkbf(sc[2 * c][2], sc[2 * c][3]);
            if (c < 4) { yw.z = pkbf(sc[(c < 4) ? 2 * c + 1 : 0][0], sc[(c < 4) ? 2 * c + 1 : 0][1]); yw.w = pkbf(sc[(c < 4) ? 2 * c + 1 : 0][2], sc[(c < 4) ? 2 * c + 1 : 0][3]); }
            else { yw.z = 0u; yw.w = 0u; }
            const bf16x8 Y = __builtin_bit_cast(bf16x8, yw);
#pragma unroll
            for (int dt = 0; dt < 4; ++dt) {
                const v4i16_t lo = vtr(vb + (32 * c) * KV_PITCH + 32 * dt), hi = vtr(vb + (32 * c + 16) * KV_PITCH + 32 * dt);
                const bf16x8 X = {lo[0], lo[1], lo[2], lo[3], hi[0], hi[1], hi[2], hi[3]};
                o[dt] = __builtin_amdgcn_mfma_f32_16x16x32_bf16(X, Y, o[dt], 0, 0, 0);
            }
        }
    }
    float inv; bf16* op;
    if (br < 3) {
        inv = __builtin_amdgcn_rcpf(lsum);
        if (fq == 0) { mA[((size_t)br * T + grow) * 16 + hh] = mx; lA[((size_t)br * T + grow) * 16 + hh] = lsum; }
        op = oA + ((size_t)br * T + grow) * 1024 + hh * 64 + 4 * fq;
    } else {
        const float m2 = __builtin_fmaxf(mx, sink_l2), cf = __builtin_amdgcn_exp2f(mx - m2);
        inv = cf * __builtin_amdgcn_rcpf(lsum * cf + __builtin_amdgcn_exp2f(sink_l2 - m2));
        op = oB + grow * 1024 + hh * 64 + 4 * fq;
    }
#pragma unroll
    for (int dt = 0; dt < 4; ++dt) { v2u w; w.x = pkbf(o[dt][0] * inv, o[dt][1] * inv); w.y = pkbf(o[dt][2] * inv, o[dt][3] * inv); *(v2u*)(op + 16 * dt) = w; }
}

__device__ __forceinline__ void attn_phase(LAS unsigned char* lds, const bf16* __restrict__ proj, const float* sinks_l,
                                           bf16* oA, bf16* oB, float* mA, float* lA, int tid, int wave, int lane) {
    int idx = blockIdx.x;
    if (idx >= N_UNITS) return;
    AU cur, nxt; v4u kr[4], vr[4]; bf16x8 q0, q1; float sink;
    au_decode(idx, cur); au_load(proj, sinks_l, cur, tid, wave, lane, kr, vr, q0, q1, sink);
    const int c8 = tid & 7, r0 = tid >> 3;
    if (tid < 128) { const int row = 256 + r0; const v4u z = {0u, 0u, 0u, 0u};
        *(LAS v4u*)(lds + LDS_KOFF + row * KV_PITCH + 16 * c8) = z; *(LAS v4u*)(lds + LDS_VOFF + row * KV_PITCH + 16 * c8) = z; }
    for (;;) {
#pragma unroll
        for (int i = 0; i < 4; ++i) { const int row = r0 + 64 * i; const bool valid = (128 * cur.qt - 128 + row) >= 0; const v4u z = {0u, 0u, 0u, 0u};
            *(LAS v4u*)(lds + LDS_KOFF + row * KV_PITCH + 16 * c8) = valid ? kr[i] : z; *(LAS v4u*)(lds + LDS_VOFF + row * KV_PITCH + 16 * c8) = valid ? vr[i] : z; }
        const bf16x8 cq0 = q0, cq1 = q1; const float csink = sink;
        __syncthreads();
        const int nidx = idx + (int)gridDim.x; const bool has_next = nidx < N_UNITS;
        if (has_next) { au_decode(nidx, nxt); au_load(proj, sinks_l, nxt, tid, wave, lane, kr, vr, q0, q1, sink); }
        attn_compute(lds, cur, cq0, cq1, csink, oA, oB, mA, lA, wave, lane);
        __syncthreads();
        if (!has_next) break;
        cur = nxt; idx = nidx;
    }
}

__device__ __forceinline__ void merge_phase(const Args& a, int layer, int wave, int lane) {
    const bf16* oA = (const bf16*)(a.ws + WS_OA); const bf16* oB = (const bf16*)(a.ws + WS_OB);
    const float* mA = (const float*)(a.ws + WS_MA); const float* lA = (const float*)(a.ws + WS_LA);
    bf16* mix = (bf16*)(a.ws + WS_MIX);
    const float* gA = a.out_norm_a + layer * 1024 + lane * 16; const float* gB = a.out_norm_b + layer * 1024 + lane * 16;
    const int gw = blockIdx.x * NWAVES + wave, NGW = gridDim.x * NWAVES, ha = lane >> 2;
    for (int t = gw; t < T; t += NGW) {
        float wgt[3]; float mxx = -INFINITY;
#pragma unroll
        for (int i = 0; i < 3; ++i) { wgt[i] = mA[((size_t)i * T + t) * 16 + ha]; mxx = __builtin_fmaxf(mxx, wgt[i]); }
        float wsum = 0.f;
#pragma unroll
        for (int i = 0; i < 3; ++i) { wgt[i] = __builtin_amdgcn_exp2f(wgt[i] - mxx) * lA[((size_t)i * T + t) * 16 + ha]; wsum += wgt[i]; }
        const float winv = 1.0f / wsum;
        float acc[16];
#pragma unroll
        for (int k = 0; k < 16; ++k) acc[k] = 0.f;
#pragma unroll
        for (int i = 0; i < 3; ++i) {
            const v4u* p = (const v4u*)(oA + ((size_t)i * T + t) * 1024 + lane * 16); const float wi = wgt[i] * winv;
#pragma unroll
            for (int h2 = 0; h2 < 2; ++h2) { const v4u q = p[h2];
#pragma unroll
                for (int k = 0; k < 4; ++k) { acc[h2 * 8 + 2 * k] += wi * __uint_as_float(q[k] << 16); acc[h2 * 8 + 2 * k + 1] += wi * __uint_as_float(q[k] & 0xffff0000u); } }
        }
        float ss = 0.f;
#pragma unroll
        for (int k = 0; k < 16; ++k) ss += acc[k] * acc[k];
        ss = wave_sum(ss);
        float rs = __builtin_amdgcn_rsqf(ss * (1.0f / 1024.f) + EPS);
        {
            v4u o0, o1; const f32x4 g0 = *(const f32x4*)(gA), g1 = *(const f32x4*)(gA + 4), g2 = *(const f32x4*)(gA + 8), g3 = *(const f32x4*)(gA + 12);
            o0.x = pkbf(acc[0] * rs * g0[0], acc[1] * rs * g0[1]); o0.y = pkbf(acc[2] * rs * g0[2], acc[3] * rs * g0[3]);
            o0.z = pkbf(acc[4] * rs * g1[0], acc[5] * rs * g1[1]); o0.w = pkbf(acc[6] * rs * g1[2], acc[7] * rs * g1[3]);
            o1.x = pkbf(acc[8] * rs * g2[0], acc[9] * rs * g2[1]); o1.y = pkbf(acc[10] * rs * g2[2], acc[11] * rs * g2[3]);
            o1.z = pkbf(acc[12] * rs * g3[0], acc[13] * rs * g3[1]); o1.w = pkbf(acc[14] * rs * g3[2], acc[15] * rs * g3[3]);
            v4u* mp = (v4u*)(mix + (size_t)t * DM + lane * 16); mp[0] = o0; mp[1] = o1;
        }
        {
            const v4u* p = (const v4u*)(oB + (size_t)t * 1024 + lane * 16);
#pragma unroll
            for (int h2 = 0; h2 < 2; ++h2) { const v4u q = p[h2];
#pragma unroll
                for (int k = 0; k < 4; ++k) { acc[h2 * 8 + 2 * k] = __uint_as_float(q[k] << 16); acc[h2 * 8 + 2 * k + 1] = __uint_as_float(q[k] & 0xffff0000u); } }
            ss = 0.f;
#pragma unroll
            for (int k = 0; k < 16; ++k) ss += acc[k] * acc[k];
            ss = wave_sum(ss);
            rs = __builtin_amdgcn_rsqf(ss * (1.0f / 1024.f) + EPS);
            v4u o0, o1; const f32x4 g0 = *(const f32x4*)(gB), g1 = *(const f32x4*)(gB + 4), g2 = *(const f32x4*)(gB + 8), g3 = *(const f32x4*)(gB + 12);
            o0.x = pkbf(acc[0] * rs * g0[0], acc[1] * rs * g0[1]); o0.y = pkbf(acc[2] * rs * g0[2], acc[3] * rs * g0[3]);
            o0.z = pkbf(acc[4] * rs * g1[0], acc[5] * rs * g1[1]); o0.w = pkbf(acc[6] * rs * g1[2], acc[7] * rs * g1[3]);
            o1.x = pkbf(acc[8] * rs * g2[0], acc[9] * rs * g2[1]); o1.y = pkbf(acc[10] * rs * g2[2], acc[11] * rs * g2[3]);
            o1.z = pkbf(acc[12] * rs * g3[0], acc[13] * rs * g3[1]); o1.w = pkbf(acc[14] * rs * g3[2], acc[15] * rs * g3[3]);
            v4u* mp = (v4u*)(mix + (size_t)t * DM + 1024 + lane * 16); mp[0] = o0; mp[1] = o1;
        }
    }
}

__device__ __forceinline__ void final_phase(const Args& a, int wave, int lane) {
    const int gw = blockIdx.x * NWAVES + wave, NGW = gridDim.x * NWAVES;
    for (int m = gw; m < T; m += NGW) {
        f32x4* xr = (f32x4*)(a.out + (size_t)m * DM) + lane; const f32x4* gr = (const f32x4*)a.final_norm + lane; f32x4 v[8]; float ss = 0.f;
#pragma unroll
        for (int j = 0; j < 8; ++j) { v[j] = xr[64 * j]; ss += dot4(v[j]); }
        ss = wave_sum(ss);
        const float rs = __builtin_amdgcn_rsqf(ss * (1.0f / DM) + EPS);
#pragma unroll
        for (int j = 0; j < 8; ++j) xr[64 * j] = v[j] * rs * gr[64 * j];
    }
}


#define RLX_AGENT __ATOMIC_RELAXED, __HIP_MEMORY_SCOPE_AGENT
#define XB_TMO      128
#define XB_XCNT(j)  (256  + 64 * (j))
#define XB_XSUB(j)  (1280 + 64 * (j))
#define XB_XGEN(j)  (2304 + 64 * (j))
#define XB_TOP      3328
#define XB_TOPGEN   3392
#define XCD_BAR_WORDS 3456
#define XB_SPIN_CAP (1u << 18)

__device__ __forceinline__ unsigned xb_ld(unsigned* p)              { return __hip_atomic_load(p, __ATOMIC_RELAXED, __HIP_MEMORY_SCOPE_AGENT); }
__device__ __forceinline__ unsigned xb_add(unsigned* p, unsigned v) { return __hip_atomic_fetch_add(p, v, __ATOMIC_RELAXED, __HIP_MEMORY_SCOPE_AGENT); }
__device__ __forceinline__ unsigned xb_xcc_id() { return (unsigned)__builtin_amdgcn_s_getreg((3 << 11) | 20) & 0xFu; }
#define XB_SPIN(cond, bar) do { unsigned _sp = 0; while (cond) { __builtin_amdgcn_s_sleep(1); \
    if ((++_sp & 255u) == 0u) { if (xb_ld(&(bar)[XB_TMO])) break; if (_sp > XB_SPIN_CAP) { atomicAdd(&(bar)[XB_TMO], 1u); break; } } } } while (0)

struct XcdBarrier {
    unsigned* bar; unsigned x;
    volatile LAS unsigned* st;
};

__device__ __forceinline__ XcdBarrier xcd_barrier_post(unsigned* bar, volatile LAS unsigned* st) {
    XcdBarrier b; b.bar = bar; b.x = xb_xcc_id(); b.st = st;
    if (threadIdx.x == 0) (void)xb_add(&bar[XB_XCNT(b.x)], 1u);
    return b;
}
__device__ __forceinline__ void xcd_barrier_complete(unsigned* bar, unsigned x, unsigned& nloc, unsigned& nx) {
    const unsigned G = gridDim.x * gridDim.y * gridDim.z;
    unsigned sum, cnt, mine, sp = 0u;
    for (;;) {
        sum = 0u; cnt = 0u; mine = 0u;
#pragma unroll
        for (unsigned j = 0; j < 16; ++j) { const unsigned c = xb_ld(&bar[XB_XCNT(j)]); sum += c; cnt += (c > 0u) ? 1u : 0u; mine = (j == x) ? c : mine; }
        if (sum == G) break;
        __builtin_amdgcn_s_sleep(1);
        if ((++sp & 255u) == 0u) { if (xb_ld(&bar[XB_TMO])) break; if (sp > XB_SPIN_CAP) { atomicAdd(&bar[XB_TMO], 1u); break; } }
    }
    nloc = mine > 0u ? mine : 1u; nx = cnt > 0u ? cnt : 1u;
}

__device__ __forceinline__ void xcd_barrier(const XcdBarrier& b) {
    asm volatile("s_waitcnt vmcnt(0)" ::: "memory");
    __syncthreads();
    if (threadIdx.x == 0) {
        unsigned* bar = b.bar;
        __builtin_amdgcn_s_waitcnt(0);
        unsigned nloc = b.st[0], nx = b.st[1];
        if (nloc == 0u) { xcd_barrier_complete(bar, b.x, nloc, nx); b.st[0] = nloc; b.st[1] = nx; }
        const unsigned old = xb_add(&bar[XB_XSUB(b.x)], 1u);
        const unsigned gen = old / nloc;
        if (old + 1u == (gen + 1u) * nloc) {
            __builtin_amdgcn_fence(__ATOMIC_RELEASE, "agent");
            asm volatile("s_waitcnt vmcnt(0)" ::: "memory");
            const unsigned og = xb_add(&bar[XB_TOP], 1u);
            const unsigned tg = og / nx;
            if (og + 1u == (tg + 1u) * nx) xb_add(&bar[XB_TOPGEN], 1u);
            else XB_SPIN(xb_ld(&bar[XB_TOPGEN]) == tg, bar);
            __builtin_amdgcn_fence(__ATOMIC_ACQUIRE, "agent");
            xb_add(&bar[XB_XGEN(b.x)], 1u);
            asm volatile("s_waitcnt vmcnt(0)" ::: "memory");
        } else {
            XB_SPIN(xb_ld(&bar[XB_XGEN(b.x)]) == gen, bar);
            __builtin_amdgcn_fence(__ATOMIC_ACQUIRE, "agent");
            asm volatile("s_waitcnt vmcnt(0)" ::: "memory");
        }
    }
    __syncthreads();
}

#ifndef PROBE_DUP
#define PROBE_DUP -1
#endif
#ifndef PROBE_P0
#define PROBE_P0 0
#endif
constexpr int PL = 6 + (PROBE_DUP >= 0 ? 1 : 0), PH0 = 1 + PROBE_P0;
constexpr int N_PHASES = PH0 + 1 + PL * DEPTH;
__global__ void __launch_bounds__(NTHREADS, 2) fwd_megakernel(Args a) {
    extern __shared__ __attribute__((aligned(16))) unsigned char lds_raw[];
    cg::grid_group grid = cg::this_grid();
    LAS unsigned char* lds = (LAS unsigned char*)lds_raw;
    bf16* xb = (bf16*)(a.ws + WS_XB); bf16* proj = (bf16*)(a.ws + WS_PROJ); bf16* mix = (bf16*)(a.ws + WS_MIX); bf16* act = (bf16*)(a.ws + WS_ACT);
    float* ssq = (float*)(a.ws + WS_SSQ);
    volatile LAS unsigned* MISC = (volatile LAS unsigned*)(lds + MISC_OFF);
    if (threadIdx.x < 32) MISC[threadIdx.x] = 0u;
    __syncthreads();
    XcdBarrier bar = xcd_barrier_post((unsigned*)(a.ws + WS_BAR), MISC + 8);
    for (int ph = a.ph_lo; ph < a.ph_hi; ++ph) {
        int tid_l = threadIdx.x; asm volatile("" : "+v"(tid_l));
        const int tid = tid_l, lane = tid & 63, wave = __builtin_amdgcn_readfirstlane(tid >> 6);
        if (ph < PH0) p0_phase(a, lds, wave, lane);
        else if (ph == N_PHASES - 1) final_phase(a, wave, lane);
        else {
            const int l = (ph - PH0) / PL, kq = (ph - PH0) - PL * l, k = (PROBE_DUP >= 0 && kq > PROBE_DUP) ? kq - 1 : kq;
            if (k == 0) {
                pg8::Gemm g{xb, (const bf16*)(a.ws + WS_WIN + l * SZ_WIN), T, IN_COLS, DM}; pg8::StaticOrder S; S.init(T, IN_COLS, (int)gridDim.x, (int)blockIdx.x);
                EpiScaleBf16 E{proj, IN_COLS, ssq};
                pg8::gemm_phase<EpiScaleBf16, pg8::StaticOrder, true, true>(lds, g, S, E);
            } else if (k == 1) {
                attn_phase(lds, proj, a.sinks + l * 16, (bf16*)(a.ws + WS_OA), (bf16*)(a.ws + WS_OB), (float*)(a.ws + WS_MA), (float*)(a.ws + WS_LA), tid, wave, lane);
            } else if (k == 2) {
                merge_phase(a, l, wave, lane);
            } else if (k == 3) {
                pg8::Gemm g{mix, (const bf16*)(a.ws + WS_WOUT + l * SZ_WOUT), T, DM, DM}; pg8::StaticOrder S; S.init(T, DM, (int)gridDim.x, (int)blockIdx.x);
                EpiResid E{a.out, xb, ssq};
                pg8::gemm_phase<EpiResid, pg8::StaticOrder, false, true>(lds, g, S, E);
            } else if (k == 4) {
                pg8::Gemm g{xb, (const bf16*)(a.ws + WS_WGU + l * SZ_WGU), T, NGU, DM}; pg8::StaticOrder S; S.init(T, NGU, (int)gridDim.x, (int)blockIdx.x);
                EpiSwiglu E{act, ssq};
                pg8::gemm_phase<EpiSwiglu, pg8::StaticOrder, true, true>(lds, g, S, E);
            } else {
                pg8::Gemm g{act, (const bf16*)(a.ws + WS_WDN + l * SZ_WDN), T, DM, DFF}; pg8::StaticOrder S; S.init(T, DM, (int)gridDim.x, (int)blockIdx.x);
                EpiResid E{a.out, xb, ssq};
                pg8::gemm_phase<EpiResid, pg8::StaticOrder, false, true>(lds, g, S, E);
            }
        }
        if (ph + 1 < a.ph_hi) { if (ph == 0) grid.sync(); else xcd_barrier(bar); }
    }
}

extern "C" void kernel_launch(void* const* d_in, const int* in_sizes, int n_in, void* d_out, int out_size, void* d_ws, size_t ws_size, hipStream_t stream) {
    static int grid = 0;
    if (grid == 0) {
        if (n_in != 12 || in_sizes[0] != T * DM || out_size != T * DM || ws_size < WS_END) { fprintf(stderr, "kernel_launch: unexpected shapes (n_in %d, out %d, ws %zu < %zu)\n", n_in, out_size, ws_size, (size_t)WS_END); grid = -1; return; }
        int dev = 0, cus = 0, per_cu = 0;
        if (hipGetDevice(&dev) != hipSuccess || hipDeviceGetAttribute(&cus, hipDeviceAttributeMultiprocessorCount, dev) != hipSuccess) { grid = -1; return; }
        if (hipFuncSetAttribute((const void*)fwd_megakernel, hipFuncAttributeMaxDynamicSharedMemorySize, LDS_BYTES) != hipSuccess) { fprintf(stderr, "kernel_launch: hipFuncSetAttribute failed\n"); grid = -1; return; }
        if (hipOccupancyMaxActiveBlocksPerMultiprocessor(&per_cu, (const void*)fwd_megakernel, NTHREADS, LDS_BYTES) != hipSuccess || per_cu < 1) per_cu = 1;
        (void)hipGetLastError();
        grid = cus * per_cu;
    }
    if (grid < 0) return;
    if (hipMemsetAsync((unsigned char*)d_ws + WS_BAR, 0, BAR_BYTES, stream) != hipSuccess) { fprintf(stderr, "kernel_launch: memset of the barrier words failed\n"); return; }
    Args a{};
    a.x = (const float*)d_in[0]; a.attn_norm = (const float*)d_in[1]; a.w_in = (const float*)d_in[2]; a.sinks = (const float*)d_in[3];
    a.out_norm_a = (const float*)d_in[4]; a.out_norm_b = (const float*)d_in[5]; a.w_out = (const float*)d_in[6]; a.ffn_norm = (const float*)d_in[7];
    a.w_gate = (const float*)d_in[8]; a.w_up = (const float*)d_in[9]; a.w_down = (const float*)d_in[10]; a.final_norm = (const float*)d_in[11];
    a.out = (float*)d_out; a.ws = (unsigned char*)d_ws; a.ph_lo = 0; a.ph_hi = N_PHASES;
    void* args[] = {&a};
    const hipError_t e = hipLaunchCooperativeKernel((const void*)fwd_megakernel, dim3(grid), dim3(NTHREADS), args, LDS_BYTES, stream);
    if (e != hipSuccess) fprintf(stderr, "kernel_launch: cooperative launch failed: %s (grid %d)\n", hipGetErrorString(e), grid);
}
```

```cpp
#include <hip/hip_runtime.h>
#include <hip/hip_cooperative_groups.h>
#include <cstdio>
#include <cstdint>
namespace cg = cooperative_groups;
namespace pg8 {
#define PG8_LAS __attribute__((address_space(3)))
typedef unsigned short bf16_t;
typedef short bf16x8 __attribute__((ext_vector_type(8)));
typedef float f32x4 __attribute__((ext_vector_type(4)));
typedef unsigned u32x4 __attribute__((ext_vector_type(4)));
constexpr int BM = 256, BK = 64, HALF = 128, HTB = HALF * BK * 2  , STAGE_BYTES = 8 * HTB, NXCD = 8, WGM = 8;

__host__ __device__ __forceinline__ int lds_byte(int r, int c) { const int st = (r >> 4) * 2 + (c >> 5), rr = r & 15, cc = c & 31, ob = rr * 64 + cc * 2; return st * 1024 + (ob ^ (((ob >> 9) & 1) << 5)); }
__host__ __device__ __forceinline__ void stage_rc(int b, int& R, int& C) { const int st = b / 1024, sb = b % 1024, swz = sb ^ (((sb >> 9) & 1) << 5); R = (st >> 1) * 16 + swz / 64; C = (st & 1) * 32 + (swz % 64) / 2; }
__host__ __device__ __forceinline__ int perm32(int rho) { const int n = rho >> 4, i = rho & 15; return 8 * (i >> 2) + 4 * n + (i & 3); }

struct Unit { int pm, pn; };
struct Gemm { const bf16_t* A; const bf16_t* Bt; int M, N, K; };

struct StaticOrder {
    int nM, nN, nwg, G, c;
    __host__ __device__ void init(int M, int N, int G_, int c_) { nM = M / BM; nN = N / BM; nwg = nM * nN; G = G_; c = c_; }
    __host__ __device__ bool next(int i, Unit& u) const {
        const long L = (long)i * G + c; if (L >= nwg) return false;
        int wgid = (int)L; { const int q = nwg / NXCD, r = nwg % NXCD, xcd = wgid % NXCD, off = wgid / NXCD; wgid = (xcd < r ? xcd * (q + 1) : r * (q + 1) + (xcd - r) * q) + off; }
        const int nig = WGM * nN, gid = wgid / nig, fm = gid * WGM, gsz = (nM - fm) < WGM ? (nM - fm) : WGM;
        u.pm = fm + ((wgid % nig) % gsz); u.pn = (wgid % nig) / gsz; return true;
    }
    __device__ __forceinline__ void a_ready(const Unit&) const {}
    __device__ __forceinline__ void done(const Unit&) const {}
};

__device__ __forceinline__ unsigned cvt_pk_bf16(float lo, float hi) { unsigned r; asm volatile("v_cvt_pk_bf16_f32 %0, %1, %2" : "=v"(r) : "v"(lo), "v"(hi)); return r; }
typedef float f32x2 __attribute__((ext_vector_type(2)));
template <class Epi, class Sched, bool ALIGN_EPI = false, bool SP2 = false>
__device__ __forceinline__ void gemm_phase(PG8_LAS unsigned char* lds, const Gemm g, const Sched& S, const Epi& E) {
    int tid_l = threadIdx.x; asm volatile("" : "+v"(tid_l));
    const int tid = tid_l, wid = __builtin_amdgcn_readfirstlane(tid >> 6), lane = tid & 63, wr = wid >> 2, wc = wid & 3, fr = lane & 15, fq = lane >> 4;
    const int K = g.K, nt = K / BK;
    unsigned voffA[2], voffB[2];
#pragma unroll
    for (int i = 0; i < 2; ++i) { int R, C; stage_rc(tid * 16 + i * 8192, R, C); const int Rb = Epi::PERM ? ((R & ~31) + perm32(R & 31)) : R;
        voffA[i] = (unsigned)(R * K + C) * 2u; voffB[i] = (unsigned)(Rb * K + C) * 2u; }
    const size_t kstep = (size_t)(BK * 2);
    const size_t hstep = (size_t)HALF * K * 2;
    const size_t tstep = 2 * hstep;
    const unsigned ldsw = (unsigned)wid * 1024u;
    const int aoff = lds_byte(wr * 64 + fr, fq * 8), boff = lds_byte(wc * 32 + fr, fq * 8);
#define PG8_SA(b, h) (((b) * 2 + (h)) * HTB)
#define PG8_SB(b, h) ((4 + (b) * 2 + (h)) * HTB)
#define PG8_STAGE(bufoff, gbase, voff) do { _Pragma("unroll") for (int _i = 0; _i < 2; ++_i) \
        __builtin_amdgcn_global_load_lds((const unsigned*)((const char*)(gbase) + (voff)[_i]), (PG8_LAS unsigned*)(lds + (bufoff) + ldsw + _i * 8192), 16, 0, 0); } while (0)
#define PG8_LDA(dst, b, h) do { _Pragma("unroll") for (int m = 0; m < 4; ++m) _Pragma("unroll") for (int k = 0; k < 2; ++k) dst[m][k] = *(const PG8_LAS bf16x8*)(lds + PG8_SA(b, h) + aoff + m * 2048 + k * 1024); } while (0)
#define PG8_LDB(dst, b, h) do { _Pragma("unroll") for (int n = 0; n < 2; ++n) _Pragma("unroll") for (int k = 0; k < 2; ++k) dst[n][k] = *(const PG8_LAS bf16x8*)(lds + PG8_SB(b, h) + boff + n * 2048 + k * 1024); } while (0)
#define PG8_MMA(ai, bj, At, Bt) do { __builtin_amdgcn_s_setprio(1); _Pragma("unroll") for (int m = 0; m < 4; ++m) _Pragma("unroll") for (int n = 0; n < 2; ++n) _Pragma("unroll") for (int k = 0; k < 2; ++k) \
        acc[ai][bj][m][n] = __builtin_amdgcn_mfma_f32_16x16x32_bf16(Bt[n][k], At[m][k], acc[ai][bj][m][n], 0, 0, 0); __builtin_amdgcn_s_setprio(0); } while (0)
#define PG8_WAIT_V(n) asm volatile("s_waitcnt vmcnt(" #n ")" ::: "memory")
#define PG8_WAIT_L(n) asm volatile("s_waitcnt lgkmcnt(" #n ")" ::: "memory")
#define PG8_BAR __builtin_amdgcn_s_barrier()
#define PG8_SCHED __builtin_amdgcn_sched_barrier(0)
    Unit cur, nxt; int ui = 0;
    if (!S.next(0, cur)) return;
    f32x4 acc[2][2][4][2];
#pragma unroll
    for (int a = 0; a < 2; ++a)
#pragma unroll
        for (int b = 0; b < 2; ++b)
#pragma unroll
            for (int m = 0; m < 4; ++m)
#pragma unroll
                for (int n = 0; n < 2; ++n) acc[a][b][m][n] = (f32x4){0.f, 0.f, 0.f, 0.f};
    bf16x8 At[4][2], B0[2][2], B1[2][2];
    const char* cA = (const char*)g.A + (size_t)cur.pm * tstep; const char* cB = (const char*)g.Bt + (size_t)cur.pn * tstep;
    S.a_ready(cur);
    if constexpr (SP2) {
        PG8_STAGE(PG8_SB(0, 0), cB, voffB); PG8_STAGE(PG8_SB(0, 1), cB + hstep, voffB); PG8_STAGE(PG8_SA(0, 0), cA, voffA); PG8_STAGE(PG8_SA(0, 1), cA + hstep, voffA);
        if (wr == 1) PG8_BAR;
        PG8_WAIT_V(2); PG8_BAR;
        PG8_STAGE(PG8_SB(1, 0), cB + kstep, voffB); PG8_STAGE(PG8_SA(1, 0), cA + kstep, voffA); PG8_STAGE(PG8_SB(1, 1), cB + hstep + kstep, voffB);
        PG8_WAIT_V(6); PG8_BAR;
    } else {
        PG8_STAGE(PG8_SB(0, 0), cB, voffB); PG8_STAGE(PG8_SA(0, 0), cA, voffA); PG8_STAGE(PG8_SB(0, 1), cB + hstep, voffB); PG8_STAGE(PG8_SA(0, 1), cA + hstep, voffA);
        if (wr == 1) PG8_BAR;
        PG8_WAIT_V(4); PG8_BAR;
        PG8_STAGE(PG8_SB(1, 0), cB + kstep, voffB); PG8_STAGE(PG8_SA(1, 0), cA + kstep, voffA); PG8_STAGE(PG8_SB(1, 1), cB + hstep + kstep, voffB);
        PG8_WAIT_V(6); PG8_BAR;
    }
    for (;;) {
        const bool has_next = S.next(ui + 1, nxt);
        const char* nA = has_next ? (const char*)g.A + (size_t)nxt.pm * tstep : cA; const char* nB = has_next ? (const char*)g.Bt + (size_t)nxt.pn * tstep : cB;
        for (int t = 0; t < nt; t += 2) {
            const bool last = (t == nt - 2);
            const char* a1 = cA + (size_t)(t + 1) * kstep;
            const char* a2 = last ? nA : cA + (size_t)(t + 2) * kstep; const char* b2 = last ? nB : cB + (size_t)(t + 2) * kstep;
            const char* a3 = a2 + kstep; const char* b3 = b2 + kstep;
            if (last && has_next) S.a_ready(nxt);
            if constexpr (SP2) {
            PG8_LDB(B0, 0, 0); PG8_LDB(B1, 0, 1); PG8_SCHED; PG8_LDA(At, 0, 0); PG8_STAGE(PG8_SA(1, 1), a1 + hstep, voffA);
            PG8_WAIT_V(8); PG8_WAIT_L(0); PG8_BAR; PG8_MMA(0, 0, At, B0); PG8_MMA(0, 1, At, B1); PG8_BAR; PG8_SCHED;
            PG8_LDA(At, 0, 1); PG8_STAGE(PG8_SB(0, 0), b2, voffB); PG8_STAGE(PG8_SB(0, 1), b2 + hstep, voffB); PG8_STAGE(PG8_SA(0, 0), a2, voffA);
            PG8_WAIT_V(8); PG8_WAIT_L(0); PG8_BAR; PG8_MMA(1, 0, At, B0); PG8_MMA(1, 1, At, B1); PG8_BAR; PG8_SCHED;
            PG8_LDB(B0, 1, 0); PG8_LDB(B1, 1, 1); PG8_SCHED; PG8_LDA(At, 1, 0); PG8_STAGE(PG8_SA(0, 1), a2 + hstep, voffA);
            PG8_WAIT_V(8); PG8_WAIT_L(0); PG8_BAR; PG8_MMA(0, 0, At, B0); PG8_MMA(0, 1, At, B1); PG8_BAR; PG8_SCHED;
            PG8_LDA(At, 1, 1); PG8_STAGE(PG8_SB(1, 0), b3, voffB); PG8_STAGE(PG8_SB(1, 1), b3 + hstep, voffB); PG8_STAGE(PG8_SA(1, 0), a3, voffA);
            PG8_WAIT_V(8); PG8_WAIT_L(0); PG8_BAR; PG8_MMA(1, 0, At, B0); PG8_MMA(1, 1, At, B1); PG8_BAR; PG8_SCHED;
            } else {
            PG8_LDB(B0, 0, 0); PG8_SCHED; PG8_LDA(At, 0, 0); PG8_STAGE(PG8_SA(1, 1), a1 + hstep, voffA);
            PG8_WAIT_L(8); PG8_BAR; PG8_WAIT_L(0); PG8_MMA(0, 0, At, B0); PG8_BAR; PG8_SCHED;
            PG8_LDB(B1, 0, 1); PG8_STAGE(PG8_SB(0, 0), b2, voffB);
            PG8_BAR; PG8_WAIT_L(0); PG8_MMA(0, 1, At, B1); PG8_BAR;
            PG8_LDA(At, 0, 1); PG8_STAGE(PG8_SA(0, 0), a2, voffA);
            PG8_BAR; PG8_WAIT_L(0); PG8_MMA(1, 0, At, B0); PG8_BAR; PG8_SCHED;
            PG8_STAGE(PG8_SB(0, 1), b2 + hstep, voffB);
            PG8_WAIT_V(6); PG8_BAR; PG8_MMA(1, 1, At, B1); PG8_BAR;
            PG8_LDB(B0, 1, 0); PG8_SCHED; PG8_LDA(At, 1, 0); PG8_STAGE(PG8_SA(0, 1), a2 + hstep, voffA);
            PG8_WAIT_L(8); PG8_BAR; PG8_WAIT_L(0); PG8_MMA(0, 0, At, B0); PG8_BAR; PG8_SCHED;
            PG8_LDB(B1, 1, 1); PG8_STAGE(PG8_SB(1, 0), b3, voffB);
            PG8_BAR; PG8_WAIT_L(0); PG8_MMA(0, 1, At, B1); PG8_BAR;
            PG8_LDA(At, 1, 1); PG8_STAGE(PG8_SA(1, 0), a3, voffA);
            PG8_BAR; PG8_WAIT_L(0); PG8_MMA(1, 0, At, B0); PG8_BAR; PG8_SCHED;
            PG8_STAGE(PG8_SB(1, 1), b3 + hstep, voffB);
            PG8_WAIT_V(6); PG8_BAR; PG8_MMA(1, 1, At, B1); PG8_BAR;
            }
        }
        if constexpr (ALIGN_EPI) { if (wr == 0) PG8_BAR; }
        if constexpr (!Epi::AFTER_DRAIN) { E(acc, cur, wr, wc, fr, fq); S.done(cur); }
        if (!has_next) break;
#pragma unroll
        for (int a = 0; a < 2; ++a)
#pragma unroll
            for (int b = 0; b < 2; ++b)
#pragma unroll
                for (int m = 0; m < 4; ++m)
#pragma unroll
                    for (int n = 0; n < 2; ++n) acc[a][b][m][n] = (f32x4){0.f, 0.f, 0.f, 0.f};
        cur = nxt; cA = nA; cB = nB; ++ui;
        if constexpr (ALIGN_EPI) { if (wr == 1) PG8_BAR; }
    }
    PG8_WAIT_V(0);
    if constexpr (!ALIGN_EPI) { if (wr == 0) PG8_BAR; }
    PG8_BAR;
    if constexpr (Epi::AFTER_DRAIN) { E.fused(acc, cur, wr, wc, fr, fq, lds, wid, lane); S.done(cur); }
#undef PG8_SA
#undef PG8_SB
#undef PG8_STAGE
#undef PG8_LDA
#undef PG8_LDB
#undef PG8_MMA
#undef PG8_WAIT_V
#undef PG8_WAIT_L
#undef PG8_BAR
#undef PG8_SCHED
}
}

#define LAS __attribute__((address_space(3)))
typedef unsigned short bf16;
typedef unsigned v4u __attribute__((ext_vector_type(4)));
typedef unsigned v2u __attribute__((ext_vector_type(2)));
typedef float f32x4 __attribute__((ext_vector_type(4)));
typedef short bf16x8 __attribute__((ext_vector_type(8)));
typedef short v4i16_t __attribute__((ext_vector_type(4)));

constexpr int BATCH = 4, SEQ = 2048, DM = 2048, DEPTH = 4;
constexpr int T = BATCH * SEQ;
constexpr int IN_COLS = 4352, DFF = 5632, NGU = 2 * DFF;
constexpr int C_QA = 0, C_KA = 1024, C_VA = 2048, C_QB = 3072, C_KB = 4096, C_VB = 4224;
constexpr float EPS = 1e-6f, LOG2E = 1.4426950408889634f;
constexpr int NWAVES = 8, NTHREADS = 512;
constexpr int LDS_BYTES = 136 * 1024;

constexpr size_t SZ_WIN = (size_t)IN_COLS * DM * 2, SZ_WOUT = (size_t)DM * DM * 2, SZ_WGU = (size_t)NGU * DM * 2, SZ_WDN = (size_t)DM * DFF * 2;
constexpr size_t WS_WIN = 0;
constexpr size_t WS_WOUT = WS_WIN + DEPTH * SZ_WIN;
constexpr size_t WS_WGU = WS_WOUT + DEPTH * SZ_WOUT;
constexpr size_t WS_WDN = WS_WGU + DEPTH * SZ_WGU;
constexpr size_t WS_XB = WS_WDN + DEPTH * SZ_WDN;
constexpr size_t WS_PROJ = WS_XB + (size_t)T * DM * 2;
constexpr size_t WS_OA = WS_PROJ + (size_t)T * IN_COLS * 2;
constexpr size_t WS_OB = WS_OA + 3 * (size_t)T * 1024 * 2;
constexpr size_t WS_MIX = WS_OB + (size_t)T * 1024 * 2;
constexpr size_t WS_ACT = WS_MIX + (size_t)T * DM * 2;
constexpr size_t WS_SSQ = WS_ACT + (size_t)T * DFF * 2;
constexpr size_t WS_MA = WS_SSQ + (size_t)T * 32 * 4;
constexpr size_t WS_LA = WS_MA + 3 * (size_t)T * 16 * 4;
constexpr size_t WS_BAR = WS_LA + 3 * (size_t)T * 16 * 4;
constexpr size_t BAR_BYTES = 16384;
constexpr size_t WS_END = WS_BAR + BAR_BYTES;
constexpr int MISC_OFF = 135168;

#define LDS_WAIT() asm volatile("s_waitcnt lgkmcnt(0)" ::: "memory")
__device__ __forceinline__ unsigned pkbf(float lo, float hi) { return pg8::cvt_pk_bf16(lo, hi); }
__device__ __forceinline__ float wave_sum(float v) {
#pragma unroll
    for (int o = 1; o < 64; o <<= 1) v += __shfl_xor(v, o);
    return v;
}
__device__ __forceinline__ float dot4(f32x4 v) { return (v[0] * v[0] + v[1] * v[1]) + (v[2] * v[2] + v[3] * v[3]); }

__device__ __forceinline__ void rows_rstd(float (&rs)[2][4], const float* ssq, int row0, int fq) {
    f32x4 pa[2][4], pb[2][4];
#pragma unroll
    for (int ai = 0; ai < 2; ++ai)
#pragma unroll
        for (int m = 0; m < 4; ++m) { const float* p = ssq + (size_t)(row0 + ai * 128 + m * 16) * 32 + 8 * fq; pa[ai][m] = *(const f32x4*)p; pb[ai][m] = *(const f32x4*)(p + 4); }
#pragma unroll
    for (int ai = 0; ai < 2; ++ai)
#pragma unroll
        for (int m = 0; m < 4; ++m) { const f32x4 a = pa[ai][m], b = pb[ai][m];
            float s = ((a[0] + a[1]) + (a[2] + a[3])) + ((b[0] + b[1]) + (b[2] + b[3]));
            s += __shfl_xor(s, 16); s += __shfl_xor(s, 32);
            rs[ai][m] = __builtin_amdgcn_rsqf(s * (1.0f / DM) + EPS); }
}
struct EpiScaleBf16 {
    static constexpr bool PERM = true, AFTER_DRAIN = false;
    bf16* O; int ldc; const float* ssq;
    __device__ __forceinline__ void operator()(const pg8::f32x4 (&acc)[2][2][4][2], const pg8::Unit& u, int wr, int wc, int fr, int fq) const {
        const int row0 = u.pm * 256 + wr * 64 + fr, col0 = u.pn * 256 + wc * 32 + 8 * fq;
        float rs[2][4]; rows_rstd(rs, ssq, row0, fq);
#pragma unroll
        for (int ai = 0; ai < 2; ++ai)
#pragma unroll
            for (int m = 0; m < 4; ++m) {
                const int row = row0 + ai * 128 + m * 16; bf16* rowp = O + (size_t)row * ldc + col0;
#pragma unroll
                for (int bj = 0; bj < 2; ++bj) { const f32x4 v0 = acc[ai][bj][m][0] * rs[ai][m], v1 = acc[ai][bj][m][1] * rs[ai][m];
                    v4u w; w.x = pkbf(v0[0], v0[1]); w.y = pkbf(v0[2], v0[3]); w.z = pkbf(v1[0], v1[1]); w.w = pkbf(v1[2], v1[3]);
                    *(v4u*)(rowp + bj * 128) = w; }
            }
    }
};
struct EpiSwiglu {
    static constexpr bool PERM = true, AFTER_DRAIN = false;
    bf16* O; const float* ssq;
    __device__ __forceinline__ void operator()(const pg8::f32x4 (&acc)[2][2][4][2], const pg8::Unit& u, int wr, int wc, int fr, int fq) const {
        const int row0 = u.pm * 256 + wr * 64 + fr, col0 = u.pn * 128 + wc * 32 + 8 * fq;
        float rs[2][4]; rows_rstd(rs, ssq, row0, fq);
#pragma unroll
        for (int ai = 0; ai < 2; ++ai)
#pragma unroll
            for (int m = 0; m < 4; ++m) {
                const int row = row0 + ai * 128 + m * 16; const float r1 = rs[ai][m];
                float a[8];
#pragma unroll
                for (int n = 0; n < 2; ++n)
#pragma unroll
                    for (int k = 0; k < 4; ++k) { const float g = acc[ai][0][m][n][k] * r1, up = acc[ai][1][m][n][k] * r1;
                        a[n * 4 + k] = g * __builtin_amdgcn_rcpf(1.0f + __builtin_amdgcn_exp2f(-g * LOG2E)) * up; }
                v4u w; w.x = pkbf(a[0], a[1]); w.y = pkbf(a[2], a[3]); w.z = pkbf(a[4], a[5]); w.w = pkbf(a[6], a[7]);
                *(v4u*)(O + (size_t)row * DFF + col0) = w;
            }
    }
};
struct EpiResid {
    static constexpr bool PERM = false, AFTER_DRAIN = false;
    float* x; bf16* xb; float* ssq;
    __device__ __forceinline__ void operator()(const pg8::f32x4 (&acc)[2][2][4][2], const pg8::Unit& u, int wr, int wc, int fr, int fq) const {
        const int row0 = u.pm * 256 + wr * 64 + fr, col0 = u.pn * 256 + wc * 32 + 4 * fq;
#pragma unroll
        for (int ai = 0; ai < 2; ++ai) {
            f32x4 xv[4][2][2];
#pragma unroll
            for (int m = 0; m < 4; ++m) { const float* xr = x + (size_t)(row0 + ai * 128 + m * 16) * DM + col0;
#pragma unroll
                for (int bj = 0; bj < 2; ++bj)
#pragma unroll
                    for (int n = 0; n < 2; ++n) xv[m][bj][n] = *(const f32x4*)(xr + bj * 128 + n * 16); }
#pragma unroll
            for (int m = 0; m < 4; ++m) {
                const int row = row0 + ai * 128 + m * 16; float* xr = x + (size_t)row * DM + col0; bf16* br = xb + (size_t)row * DM + col0; float ss = 0.f;
#pragma unroll
                for (int bj = 0; bj < 2; ++bj)
#pragma unroll
                    for (int n = 0; n < 2; ++n) { const int off = bj * 128 + n * 16; const f32x4 v = xv[m][bj][n] + acc[ai][bj][m][n];
                        *(f32x4*)(xr + off) = v; v2u w; w.x = pkbf(v[0], v[1]); w.y = pkbf(v[2], v[3]); *(v2u*)(br + off) = w; ss += dot4(v); }
                ss += __shfl_xor(ss, 16); ss += __shfl_xor(ss, 32);
                if (fq == 0) ssq[(size_t)row * 32 + u.pn * 4 + wc] = ss;
            }
        }
    }
};

__device__ __forceinline__ void p0_item(const float* __restrict__ W, int K, int N, bf16* WT, const float* g, int mode, LAS float* scr, int item, int lane) {
    const int nblk = N >> 6, kb = item / nblk, nb = item - kb * nblk, k0 = kb << 6, n0 = nb << 6;
    f32x4 v[16];
    const float* src = W + (size_t)(k0 + (lane >> 4)) * N + n0 + 4 * (lane & 15);
#pragma unroll
    for (int i = 0; i < 16; ++i) v[i] = *(const f32x4*)(src + (size_t)(4 * i) * N);
#pragma unroll
    for (int i = 0; i < 16; ++i) { LAS float* d = scr + (4 * i + (lane >> 4)) * 65 + 4 * (lane & 15); d[0] = v[i][0]; d[1] = v[i][1]; d[2] = v[i][2]; d[3] = v[i][3]; }
    LDS_WAIT();
    const int c = lane & 7;
    f32x4 g0 = {1.f, 1.f, 1.f, 1.f}, g1 = {1.f, 1.f, 1.f, 1.f};
    if (g) { g0 = *(const f32x4*)(g + k0 + 8 * c); g1 = *(const f32x4*)(g + k0 + 8 * c + 4); }
#pragma unroll
    for (int j = 0; j < 8; ++j) {
        const int n = (lane >> 3) + 8 * j; const LAS float* s = scr + (8 * c) * 65 + n;
        v4u o; o.x = pkbf(s[0] * g0[0], s[65] * g0[1]); o.y = pkbf(s[130] * g0[2], s[195] * g0[3]); o.z = pkbf(s[260] * g1[0], s[325] * g1[1]); o.w = pkbf(s[390] * g1[2], s[455] * g1[3]);
        const int nn = n0 + n; const int row = (mode == 0) ? nn : (((nn >> 7) << 8) + (nn & 127) + (mode == 2 ? 128 : 0));
        *(v4u*)(WT + (size_t)row * K + k0 + 8 * c) = o;
    }
    LDS_WAIT();
}

struct Args {
    const float* x; const float* attn_norm; const float* w_in; const float* sinks; const float* out_norm_a; const float* out_norm_b;
    const float* w_out; const float* ffn_norm; const float* w_gate; const float* w_up; const float* w_down; const float* final_norm;
    float* out; unsigned char* ws; int ph_lo, ph_hi;
};

constexpr int I_IN = (DM / 64) * (IN_COLS / 64), I_OUT = (DM / 64) * (DM / 64), I_G = (DM / 64) * (DFF / 64), I_D = (DFF / 64) * (DM / 64);
constexpr int I_FRONT = I_IN + I_OUT + I_G, I_LAYER = I_FRONT + I_G + I_D;
__device__ __forceinline__ void p0_layer_items(const Args& a, int l, int lo, int hi, int ww, int nww, LAS unsigned char* lds, int wave, int lane) {
    LAS float* scr = (LAS float*)(lds + wave * 16640);
    for (int it = lo + ww; it < hi; it += nww) {
        int r = it;
        if (r < I_IN) { p0_item(a.w_in + (size_t)l * DM * IN_COLS, DM, IN_COLS, (bf16*)(a.ws + WS_WIN + l * SZ_WIN), a.attn_norm + l * DM, 0, scr, r, lane); continue; } r -= I_IN;
        if (r < I_OUT) { p0_item(a.w_out + (size_t)l * DM * DM, DM, DM, (bf16*)(a.ws + WS_WOUT + l * SZ_WOUT), nullptr, 0, scr, r, lane); continue; } r -= I_OUT;
        if (r < I_G) { p0_item(a.w_gate + (size_t)l * DM * DFF, DM, DFF, (bf16*)(a.ws + WS_WGU + l * SZ_WGU), a.ffn_norm + l * DM, 1, scr, r, lane); continue; } r -= I_G;
        if (r < I_G) { p0_item(a.w_up + (size_t)l * DM * DFF, DM, DFF, (bf16*)(a.ws + WS_WGU + l * SZ_WGU), a.ffn_norm + l * DM, 2, scr, r, lane); continue; } r -= I_G;
        p0_item(a.w_down + (size_t)l * DFF * DM, DFF, DM, (bf16*)(a.ws + WS_WDN + l * SZ_WDN), nullptr, 0, scr, r, lane);
    }
}
__device__ __forceinline__ void p0_in_tail(const Args& a, int l, int lo, int hi, int nunits, LAS unsigned char* lds, int wave, int lane) {
    const int G = (int)gridDim.x, busy = nunits - ((nunits - 1) / G) * G;
    if (busy >= G) p0_layer_items(a, l, lo, hi, (int)blockIdx.x * NWAVES + wave, G * NWAVES, lds, wave, lane);
    else if ((int)blockIdx.x >= busy) p0_layer_items(a, l, lo, hi, ((int)blockIdx.x - busy) * NWAVES + wave, (G - busy) * NWAVES, lds, wave, lane);
}
__device__ __forceinline__ void p0_phase(const Args& a, LAS unsigned char* lds, int wave, int lane) {
    const int gw = blockIdx.x * NWAVES + wave, NGW = gridDim.x * NWAVES;
    p0_layer_items(a, 0, 0, I_LAYER, gw, NGW, lds, wave, lane);
    bf16* xb = (bf16*)(a.ws + WS_XB); float* ssq = (float*)(a.ws + WS_SSQ);
    for (int m = gw; m < T; m += NGW) {
        const f32x4* xr = (const f32x4*)(a.x + (size_t)m * DM) + lane; f32x4 v[8]; float ss = 0.f;
#pragma unroll
        for (int j = 0; j < 8; ++j) { v[j] = xr[64 * j]; ss += dot4(v[j]); }
        ss = wave_sum(ss);
        f32x4* orow = (f32x4*)(a.out + (size_t)m * DM) + lane; v2u* brow = (v2u*)(xb + (size_t)m * DM) + lane;
#pragma unroll
        for (int j = 0; j < 8; ++j) { orow[64 * j] = v[j]; v2u w; w.x = pkbf(v[j][0], v[j][1]); w.y = pkbf(v[j][2], v[j][3]); brow[64 * j] = w; }
        if (lane < 32) ssq[(size_t)m * 32 + lane] = (lane == 0) ? ss : 0.f;
    }
}

constexpr int KV_PITCH = 144, KV_ROWS = 272, LDS_KOFF = 0, LDS_VOFF = KV_ROWS * KV_PITCH;
constexpr int N_UNITS_A = 3 * 1024, N_UNITS = N_UNITS_A + 1024;
__device__ __forceinline__ v4i16_t vtr(const LAS unsigned char* p) { return __builtin_amdgcn_ds_read_tr16_b64_v4i16((LAS v4i16_t*)p); }

struct AU { int d, b, r, qt, qcol, kcol, vcol, br, hh; };
__device__ __forceinline__ void au_decode(int idx, AU& u) {
    if (idx < N_UNITS_A) {
        u.br = idx >> 10; const int rem = idx & 1023; u.d = (u.br == 0) ? 1 : (u.br == 1 ? 4 : 16);
        u.b = rem >> 8; u.hh = (rem >> 4) & 15; const int nqt = 16 / u.d, w16 = rem & 15; u.r = w16 / nqt; u.qt = w16 - u.r * nqt;
        u.qcol = C_QA + u.hh * 64; u.kcol = C_KA + u.hh * 64; u.vcol = C_VA + u.hh * 64;
    } else {
        u.br = 3; const int rem = idx - N_UNITS_A; u.d = 1; u.r = 0;
        u.b = rem >> 8; const int g = (rem >> 7) & 1, rr = (rem >> 4) & 7; u.qt = rem & 15; u.hh = g * 8 + rr;
        u.qcol = C_QB + u.hh * 64; u.kcol = C_KB + g * 64; u.vcol = C_VB + g * 64;
    }
}
__device__ __forceinline__ void au_load(const bf16* __restrict__ proj, const float* sinks_l, const AU& u, int tid, int wave, int lane, v4u (&kr)[4], v4u (&vr)[4], bf16x8& q0, bf16x8& q1, float& sink) {
    const int c8 = tid & 7, r0 = tid >> 3;
#pragma unroll
    for (int i = 0; i < 4; ++i) {
        const int row = r0 + 64 * i; int ks = 128 * u.qt - 128 + row; ks = ks < 0 ? 0 : ks;
        const bf16* p = proj + (size_t)(u.b * SEQ + u.r + u.d * ks) * IN_COLS + 8 * c8; kr[i] = *(const v4u*)(p + u.kcol); vr[i] = *(const v4u*)(p + u.vcol);
    }
    const int iq = 128 * u.qt + 16 * wave + (lane & 15);
    const bf16* qp = proj + (size_t)(u.b * SEQ + u.r + u.d * iq) * IN_COLS + u.qcol + 8 * (lane >> 4);
    q0 = *(const bf16x8*)qp; q1 = *(const bf16x8*)(qp + 32);
    sink = sinks_l[u.hh];
}

__device__ __forceinline__ void attn_compute(LAS unsigned char* lds, const AU& u, const bf16x8 q0, const bf16x8 q1, const float sink,
                                             bf16* oA, bf16* oB, float* mA, float* lA, int wave, int lane) {
    const int d = u.d, qt = u.qt, br = u.br, hh = u.hh;
    float slope, maxd, sink_l2 = 0.f;
    if (br < 3) { slope = __builtin_amdgcn_exp2f(-(float)(2 * hh + 1) * 0.25f); maxd = 128.f; }
    else { slope = __builtin_amdgcn_exp2f(-(float)(hh + 1) * 0.5f); maxd = 127.f; sink_l2 = sink * LOG2E; }
    const float sl2 = slope * (float)d * LOG2E;
    const float C2 = 0.125f * LOG2E;
    const int fr = lane & 15, fq = lane >> 4;
    const int iq = 128 * qt + 16 * wave + fr;
    const size_t grow = (size_t)(u.b * SEQ + u.r + d * iq);
    f32x4 sc[9];
    {
        const LAS unsigned char* kb = lds + LDS_KOFF + (16 * wave + fr) * KV_PITCH + 16 * fq;
#pragma unroll
        for (int j = 0; j < 9; ++j) {
            const bf16x8 k0 = *(const LAS bf16x8*)(kb + j * 16 * KV_PITCH), k1 = *(const LAS bf16x8*)(kb + j * 16 * KV_PITCH + 64);
            f32x4 z = {0.f, 0.f, 0.f, 0.f};
            z = __builtin_amdgcn_mfma_f32_16x16x32_bf16(k0, q0, z, 0, 0, 0);
            sc[j] = __builtin_amdgcn_mfma_f32_16x16x32_bf16(k1, q1, z, 0, 0, 0);
        }
    }
    const float bl = (float)(fr - 4 * fq);
    const bool early = (qt == 0);
    float mx = -INFINITY;
#pragma unroll
    for (int j = 0; j < 9; ++j)
#pragma unroll
        for (int jj = 0; jj < 4; ++jj) {
            const float dist = (float)(128 - 16 * j - jj) + bl;
            float v = __builtin_fmaf(sc[j][jj], C2, -sl2 * dist);
            bool ok = true;
            if (j == 0) ok = dist <= maxd;
            if (j == 8) ok = dist >= 0.f;
            if (early && (wave + j < 8)) ok = false;
            v = ok ? v : -INFINITY; sc[j][jj] = v; mx = __builtin_fmaxf(mx, v);
        }
    mx = __builtin_fmaxf(mx, __shfl_xor(mx, 16)); mx = __builtin_fmaxf(mx, __shfl_xor(mx, 32));
    float lsum = 0.f;
#pragma unroll
    for (int j = 0; j < 9; ++j)
#pragma unroll
        for (int jj = 0; jj < 4; ++jj) { const float p = __builtin_amdgcn_exp2f(sc[j][jj] - mx); sc[j][jj] = p; lsum += p; }
    lsum += __shfl_xor(lsum, 16); lsum += __shfl_xor(lsum, 32);
    f32x4 o[4];
#pragma unroll
    for (int dt = 0; dt < 4; ++dt) o[dt] = (f32x4){0.f, 0.f, 0.f, 0.f};
    {
        const int q4 = (lane & 15) >> 2, p4 = lane & 3;
        const LAS unsigned char* vb = lds + LDS_VOFF + (16 * wave + 4 * fq + q4) * KV_PITCH + 8 * p4;
#pragma unroll
        for (int c = 0; c < 5; ++c) {
            v4u yw; yw.x = pkbf(sc[2 * c][0], sc[2 * c][1]); yw.y = pkbf(sc[2 * c][2], sc[2 * c][3]);
            if (c < 4) { yw.z = pkbf(sc[(c < 4) ? 2 * c + 1 : 0][0], sc[(c < 4) ? 2 * c + 1 : 0][1]); yw.w = pkbf(sc[(c < 4) ? 2 * c + 1 : 0][2], sc[(c < 4) ? 2 * c + 1 : 0][3]); }
            else { yw.z = 0u; yw.w = 0u; }
            const bf16x8 Y = __builtin_bit_cast(bf16x8, yw);
#pragma unroll
            for (int dt = 0; dt < 4; ++dt) {
                const v4i16_t lo = vtr(vb + (32 * c) * KV_PITCH + 32 * dt), hi = vtr(vb + (32 * c + 16) * KV_PITCH + 32 * dt);
                const bf16x8 X = {lo[0], lo[1], lo[2], lo[3], hi[0], hi[1], hi[2], hi[3]};
                o[dt] = __builtin_amdgcn_mfma_f32_16x16x32_bf16(X, Y, o[dt], 0, 0, 0);
            }
        }
    }
    float inv; bf16* op;
    if (br < 3) {
        inv = __builtin_amdgcn_rcpf(lsum);
        if (fq == 0) { mA[((size_t)br * T + grow) * 16 + hh] = mx; lA[((size_t)br * T + grow) * 16 + hh] = lsum; }
        op = oA + ((size_t)br * T + grow) * 1024 + hh * 64 + 4 * fq;
    } else {
        const float m2 = __builtin_fmaxf(mx, sink_l2), cf = __builtin_amdgcn_exp2f(mx - m2);
        inv = cf * __builtin_amdgcn_rcpf(lsum * cf + __builtin_amdgcn_exp2f(sink_l2 - m2));
        op = oB + grow * 1024 + hh * 64 + 4 * fq;
    }
#pragma unroll
    for (int dt = 0; dt < 4; ++dt) { v2u w; w.x = pkbf(o[dt][0] * inv, o[dt][1] * inv); w.y = pkbf(o[dt][2] * inv, o[dt][3] * inv); *(v2u*)(op + 16 * dt) = w; }
}

__device__ __forceinline__ void attn_phase(LAS unsigned char* lds, const bf16* __restrict__ proj, const float* sinks_l,
                                           bf16* oA, bf16* oB, float* mA, float* lA, int tid, int wave, int lane) {
    int idx = blockIdx.x;
    if (idx >= N_UNITS) return;
    AU cur, nxt; v4u kr[4], vr[4]; bf16x8 q0, q1; float sink;
    au_decode(idx, cur); au_load(proj, sinks_l, cur, tid, wave, lane, kr, vr, q0, q1, sink);
    const int c8 = tid & 7, r0 = tid >> 3;
    if (tid < 128) { const int row = 256 + r0; const v4u z = {0u, 0u, 0u, 0u};
        *(LAS v4u*)(lds + LDS_KOFF + row * KV_PITCH + 16 * c8) = z; *(LAS v4u*)(lds + LDS_VOFF + row * KV_PITCH + 16 * c8) = z; }
    for (;;) {
#pragma unroll
        for (int i = 0; i < 4; ++i) { const int row = r0 + 64 * i; const bool valid = (128 * cur.qt - 128 + row) >= 0; const v4u z = {0u, 0u, 0u, 0u};
            *(LAS v4u*)(lds + LDS_KOFF + row * KV_PITCH + 16 * c8) = valid ? kr[i] : z; *(LAS v4u*)(lds + LDS_VOFF + row * KV_PITCH + 16 * c8) = valid ? vr[i] : z; }
        const bf16x8 cq0 = q0, cq1 = q1; const float csink = sink;
        __syncthreads();
        const int nidx = idx + (int)gridDim.x; const bool has_next = nidx < N_UNITS;
        if (has_next) { au_decode(nidx, nxt); au_load(proj, sinks_l, nxt, tid, wave, lane, kr, vr, q0, q1, sink); }
        attn_compute(lds, cur, cq0, cq1, csink, oA, oB, mA, lA, wave, lane);
        __syncthreads();
        if (!has_next) break;
        cur = nxt; idx = nidx;
    }
}

__device__ __forceinline__ void merge_phase(const Args& a, int layer, int wave, int lane) {
    const bf16* oA = (const bf16*)(a.ws + WS_OA); const bf16* oB = (const bf16*)(a.ws + WS_OB);
    const float* mA = (const float*)(a.ws + WS_MA); const float* lA = (const float*)(a.ws + WS_LA);
    bf16* mix = (bf16*)(a.ws + WS_MIX);
    const float* gA = a.out_norm_a + layer * 1024 + lane * 16; const float* gB = a.out_norm_b + layer * 1024 + lane * 16;
    const int gw = blockIdx.x * NWAVES + wave, NGW = gridDim.x * NWAVES, ha = lane >> 2;
    for (int t = gw; t < T; t += NGW) {
        float wgt[3]; float mxx = -INFINITY;
#pragma unroll
        for (int i = 0; i < 3; ++i) { wgt[i] = mA[((size_t)i * T + t) * 16 + ha]; mxx = __builtin_fmaxf(mxx, wgt[i]); }
        float wsum = 0.f;
#pragma unroll
        for (int i = 0; i < 3; ++i) { wgt[i] = __builtin_amdgcn_exp2f(wgt[i] - mxx) * lA[((size_t)i * T + t) * 16 + ha]; wsum += wgt[i]; }
        const float winv = 1.0f / wsum;
        float acc[16];
#pragma unroll
        for (int k = 0; k < 16; ++k) acc[k] = 0.f;
#pragma unroll
        for (int i = 0; i < 3; ++i) {
            const v4u* p = (const v4u*)(oA + ((size_t)i * T + t) * 1024 + lane * 16); const float wi = wgt[i] * winv;
#pragma unroll
            for (int h2 = 0; h2 < 2; ++h2) { const v4u q = p[h2];
#pragma unroll
                for (int k = 0; k < 4; ++k) { acc[h2 * 8 + 2 * k] += wi * __uint_as_float(q[k] << 16); acc[h2 * 8 + 2 * k + 1] += wi * __uint_as_float(q[k] & 0xffff0000u); } }
        }
        float ss = 0.f;
#pragma unroll
        for (int k = 0; k < 16; ++k) ss += acc[k] * acc[k];
        ss = wave_sum(ss);
        float rs = __builtin_amdgcn_rsqf(ss * (1.0f / 1024.f) + EPS);
        {
            v4u o0, o1; const f32x4 g0 = *(const f32x4*)(gA), g1 = *(const f32x4*)(gA + 4), g2 = *(const f32x4*)(gA + 8), g3 = *(const f32x4*)(gA + 12);
            o0.x = pkbf(acc[0] * rs * g0[0], acc[1] * rs * g0[1]); o0.y = pkbf(acc[2] * rs * g0[2], acc[3] * rs * g0[3]);
            o0.z = pkbf(acc[4] * rs * g1[0], acc[5] * rs * g1[1]); o0.w = pkbf(acc[6] * rs * g1[2], acc[7] * rs * g1[3]);
            o1.x = pkbf(acc[8] * rs * g2[0], acc[9] * rs * g2[1]); o1.y = pkbf(acc[10] * rs * g2[2], acc[11] * rs * g2[3]);
            o1.z = pkbf(acc[12] * rs * g3[0], acc[13] * rs * g3[1]); o1.w = pkbf(acc[14] * rs * g3[2], acc[15] * rs * g3[3]);
            v4u* mp = (v4u*)(mix + (size_t)t * DM + lane * 16); mp[0] = o0; mp[1] = o1;
        }
        {
            const v4u* p = (const v4u*)(oB + (size_t)t * 1024 + lane * 16);
#pragma unroll
            for (int h2 = 0; h2 < 2; ++h2) { const v4u q = p[h2];
#pragma unroll
                for (int k = 0; k < 4; ++k) { acc[h2 * 8 + 2 * k] = __uint_as_float(q[k] << 16); acc[h2 * 8 + 2 * k + 1] = __uint_as_float(q[k] & 0xffff0000u); } }
            ss = 0.f;
#pragma unroll
            for (int k = 0; k < 16; ++k) ss += acc[k] * acc[k];
            ss = wave_sum(ss);
            rs = __builtin_amdgcn_rsqf(ss * (1.0f / 1024.f) + EPS);
            v4u o0, o1; const f32x4 g0 = *(const f32x4*)(gB), g1 = *(const f32x4*)(gB + 4), g2 = *(const f32x4*)(gB + 8), g3 = *(const f32x4*)(gB + 12);
            o0.x = pkbf(acc[0] * rs * g0[0], acc[1] * rs * g0[1]); o0.y = pkbf(acc[2] * rs * g0[2], acc[3] * rs * g0[3]);
            o0.z = pkbf(acc[4] * rs * g1[0], acc[5] * rs * g1[1]); o0.w = pkbf(acc[6] * rs * g1[2], acc[7] * rs * g1[3]);
            o1.x = pkbf(acc[8] * rs * g2[0], acc[9] * rs * g2[1]); o1.y = pkbf(acc[10] * rs * g2[2], acc[11] * rs * g2[3]);
            o1.z = pkbf(acc[12] * rs * g3[0], acc[13] * rs * g3[1]); o1.w = pkbf(acc[14] * rs * g3[2], acc[15] * rs * g3[3]);
            v4u* mp = (v4u*)(mix + (size_t)t * DM + 1024 + lane * 16); mp[0] = o0; mp[1] = o1;
        }
    }
}

__device__ __forceinline__ void final_phase(const Args& a, int wave, int lane) {
    const int gw = blockIdx.x * NWAVES + wave, NGW = gridDim.x * NWAVES;
    for (int m = gw; m < T; m += NGW) {
        f32x4* xr = (f32x4*)(a.out + (size_t)m * DM) + lane; const f32x4* gr = (const f32x4*)a.final_norm + lane; f32x4 v[8]; float ss = 0.f;
#pragma unroll
        for (int j = 0; j < 8; ++j) { v[j] = xr[64 * j]; ss += dot4(v[j]); }
        ss = wave_sum(ss);
        const float rs = __builtin_amdgcn_rsqf(ss * (1.0f / DM) + EPS);
#pragma unroll
        for (int j = 0; j < 8; ++j) xr[64 * j] = v[j] * rs * gr[64 * j];
    }
}


#define RLX_AGENT __ATOMIC_RELAXED, __HIP_MEMORY_SCOPE_AGENT
#define XB_TMO      128
#define XB_XCNT(j)  (256  + 64 * (j))
#define XB_XSUB(j)  (1280 + 64 * (j))
#define XB_XGEN(j)  (2304 + 64 * (j))
#define XB_TOP      3328
#define XB_TOPGEN   3392
#define XCD_BAR_WORDS 3456
#define XB_SPIN_CAP (1u << 18)

__device__ __forceinline__ unsigned xb_ld(unsigned* p)              { return __hip_atomic_load(p, __ATOMIC_RELAXED, __HIP_MEMORY_SCOPE_AGENT); }
__device__ __forceinline__ unsigned xb_add(unsigned* p, unsigned v) { return __hip_atomic_fetch_add(p, v, __ATOMIC_RELAXED, __HIP_MEMORY_SCOPE_AGENT); }
__device__ __forceinline__ unsigned xb_xcc_id() { return (unsigned)__builtin_amdgcn_s_getreg((3 << 11) | 20) & 0xFu; }
#define XB_SPIN(cond, bar) do { unsigned _sp = 0; while (cond) { __builtin_amdgcn_s_sleep(1); \
    if ((++_sp & 255u) == 0u) { if (xb_ld(&(bar)[XB_TMO])) break; if (_sp > XB_SPIN_CAP) { atomicAdd(&(bar)[XB_TMO], 1u); break; } } } } while (0)

struct XcdBarrier {
    unsigned* bar; unsigned x;
    volatile LAS unsigned* st;
};

__device__ __forceinline__ XcdBarrier xcd_barrier_post(unsigned* bar, volatile LAS unsigned* st) {
    XcdBarrier b; b.bar = bar; b.x = xb_xcc_id(); b.st = st;
    if (threadIdx.x == 0) (void)xb_add(&bar[XB_XCNT(b.x)], 1u);
    return b;
}
__device__ __forceinline__ void xcd_barrier_complete(unsigned* bar, unsigned x, unsigned& nloc, unsigned& nx) {
    const unsigned G = gridDim.x * gridDim.y * gridDim.z;
    unsigned sum, cnt, mine, sp = 0u;
    for (;;) {
        sum = 0u; cnt = 0u; mine = 0u;
#pragma unroll
        for (unsigned j = 0; j < 16; ++j) { const unsigned c = xb_ld(&bar[XB_XCNT(j)]); sum += c; cnt += (c > 0u) ? 1u : 0u; mine = (j == x) ? c : mine; }
        if (sum == G) break;
        __builtin_amdgcn_s_sleep(1);
        if ((++sp & 255u) == 0u) { if (xb_ld(&bar[XB_TMO])) break; if (sp > XB_SPIN_CAP) { atomicAdd(&bar[XB_TMO], 1u); break; } }
    }
    nloc = mine > 0u ? mine : 1u; nx = cnt > 0u ? cnt : 1u;
}

__device__ __forceinline__ void xcd_barrier(const XcdBarrier& b) {
    asm volatile("s_waitcnt vmcnt(0)" ::: "memory");
    __syncthreads();
    if (threadIdx.x == 0) {
        unsigned* bar = b.bar;
        __builtin_amdgcn_s_waitcnt(0);
        unsigned nloc = b.st[0], nx = b.st[1];
        if (nloc == 0u) { xcd_barrier_complete(bar, b.x, nloc, nx); b.st[0] = nloc; b.st[1] = nx; }
        const unsigned old = xb_add(&bar[XB_XSUB(b.x)], 1u);
        const unsigned gen = old / nloc;
        if (old + 1u == (gen + 1u) * nloc) {
            __builtin_amdgcn_fence(__ATOMIC_RELEASE, "agent");
            asm volatile("s_waitcnt vmcnt(0)" ::: "memory");
            const unsigned og = xb_add(&bar[XB_TOP], 1u);
            const unsigned tg = og / nx;
            if (og + 1u == (tg + 1u) * nx) xb_add(&bar[XB_TOPGEN], 1u);
            else XB_SPIN(xb_ld(&bar[XB_TOPGEN]) == tg, bar);
            __builtin_amdgcn_fence(__ATOMIC_ACQUIRE, "agent");
            xb_add(&bar[XB_XGEN(b.x)], 1u);
            asm volatile("s_waitcnt vmcnt(0)" ::: "memory");
        } else {
            XB_SPIN(xb_ld(&bar[XB_XGEN(b.x)]) == gen, bar);
            __builtin_amdgcn_fence(__ATOMIC_ACQUIRE, "agent");
            asm volatile("s_waitcnt vmcnt(0)" ::: "memory");
        }
    }
    __syncthreads();
}

#ifndef PROBE_DUP
#define PROBE_DUP -1
#endif
#ifndef PROBE_P0
#define PROBE_P0 0
#endif
constexpr int PL = 6 + (PROBE_DUP >= 0 ? 1 : 0), PH0 = 1 + PROBE_P0;
constexpr int N_PHASES = PH0 + 1 + PL * DEPTH;
__global__ void __launch_bounds__(NTHREADS, 2) fwd_megakernel(Args a) {
    extern __shared__ __attribute__((aligned(16))) unsigned char lds_raw[];
    cg::grid_group grid = cg::this_grid();
    LAS unsigned char* lds = (LAS unsigned char*)lds_raw;
    bf16* xb = (bf16*)(a.ws + WS_XB); bf16* proj = (bf16*)(a.ws + WS_PROJ); bf16* mix = (bf16*)(a.ws + WS_MIX); bf16* act = (bf16*)(a.ws + WS_ACT);
    float* ssq = (float*)(a.ws + WS_SSQ);
    volatile LAS unsigned* MISC = (volatile LAS unsigned*)(lds + MISC_OFF);
    if (threadIdx.x < 32) MISC[threadIdx.x] = 0u;
    __syncthreads();
    XcdBarrier bar = xcd_barrier_post((unsigned*)(a.ws + WS_BAR), MISC + 8);
    for (int ph = a.ph_lo; ph < a.ph_hi; ++ph) {
        int tid_l = threadIdx.x; asm volatile("" : "+v"(tid_l));
        const int tid = tid_l, lane = tid & 63, wave = __builtin_amdgcn_readfirstlane(tid >> 6);
        if (ph < PH0) p0_phase(a, lds, wave, lane);
        else if (ph == N_PHASES - 1) final_phase(a, wave, lane);
        else {
            const int l = (ph - PH0) / PL, kq = (ph - PH0) - PL * l, k = (PROBE_DUP >= 0 && kq > PROBE_DUP) ? kq - 1 : kq;
            if (k == 0) {
                pg8::Gemm g{xb, (const bf16*)(a.ws + WS_WIN + l * SZ_WIN), T, IN_COLS, DM}; pg8::StaticOrder S; S.init(T, IN_COLS, (int)gridDim.x, (int)blockIdx.x);
                EpiScaleBf16 E{proj, IN_COLS, ssq};
                pg8::gemm_phase<EpiScaleBf16, pg8::StaticOrder, true, true>(lds, g, S, E);
                if (l + 1 < DEPTH) p0_in_tail(a, l + 1, 0, I_FRONT, (T / 256) * (IN_COLS / 256), lds, wave, lane);
            } else if (k == 1) {
                attn_phase(lds, proj, a.sinks + l * 16, (bf16*)(a.ws + WS_OA), (bf16*)(a.ws + WS_OB), (float*)(a.ws + WS_MA), (float*)(a.ws + WS_LA), tid, wave, lane);
            } else if (k == 2) {
                merge_phase(a, l, wave, lane);
            } else if (k == 3) {
                pg8::Gemm g{mix, (const bf16*)(a.ws + WS_WOUT + l * SZ_WOUT), T, DM, DM}; pg8::StaticOrder S; S.init(T, DM, (int)gridDim.x, (int)blockIdx.x);
                EpiResid E{a.out, xb, ssq};
                pg8::gemm_phase<EpiResid, pg8::StaticOrder, false, true>(lds, g, S, E);
            } else if (k == 4) {
                pg8::Gemm g{xb, (const bf16*)(a.ws + WS_WGU + l * SZ_WGU), T, NGU, DM}; pg8::StaticOrder S; S.init(T, NGU, (int)gridDim.x, (int)blockIdx.x);
                EpiSwiglu E{act, ssq};
                pg8::gemm_phase<EpiSwiglu, pg8::StaticOrder, true, true>(lds, g, S, E);
                if (l + 1 < DEPTH) p0_in_tail(a, l + 1, I_FRONT, I_LAYER, (T / 256) * (NGU / 256), lds, wave, lane);
            } else {
                pg8::Gemm g{act, (const bf16*)(a.ws + WS_WDN + l * SZ_WDN), T, DM, DFF}; pg8::StaticOrder S; S.init(T, DM, (int)gridDim.x, (int)blockIdx.x);
                EpiResid E{a.out, xb, ssq};
                pg8::gemm_phase<EpiResid, pg8::StaticOrder, false, true>(lds, g, S, E);
            }
        }
        if (ph + 1 < a.ph_hi) { if (ph == 0) grid.sync(); else xcd_barrier(bar); }
    }
}

extern "C" void kernel_launch(void* const* d_in, const int* in_sizes, int n_in, void* d_out, int out_size, void* d_ws, size_t ws_size, hipStream_t stream) {
    static int grid = 0;
    if (grid == 0) {
        if (n_in != 12 || in_sizes[0] != T * DM || out_size != T * DM || ws_size < WS_END) { fprintf(stderr, "kernel_launch: unexpected shapes (n_in %d, out %d, ws %zu < %zu)\n", n_in, out_size, ws_size, (size_t)WS_END); grid = -1; return; }
        int dev = 0, cus = 0, per_cu = 0;
        if (hipGetDevice(&dev) != hipSuccess || hipDeviceGetAttribute(&cus, hipDeviceAttributeMultiprocessorCount, dev) != hipSuccess) { grid = -1; return; }
        if (hipFuncSetAttribute((const void*)fwd_megakernel, hipFuncAttributeMaxDynamicSharedMemorySize, LDS_BYTES) != hipSuccess) { fprintf(stderr, "kernel_launch: hipFuncSetAttribute failed\n"); grid = -1; return; }
        if (hipOccupancyMaxActiveBlocksPerMultiprocessor(&per_cu, (const void*)fwd_megakernel, NTHREADS, LDS_BYTES) != hipSuccess || per_cu < 1) per_cu = 1;
        (void)hipGetLastError();
        grid = cus * per_cu;
    }
    if (grid < 0) return;
    if (hipMemsetAsync((unsigned char*)d_ws + WS_BAR, 0, BAR_BYTES, stream) != hipSuccess) { fprintf(stderr, "kernel_launch: memset of the barrier words failed\n"); return; }
    Args a{};
    a.x = (const float*)d_in[0]; a.attn_norm = (const float*)d_in[1]; a.w_in = (const float*)d_in[2]; a.sinks = (const float*)d_in[3];
    a.out_norm_a = (const float*)d_in[4]; a.out_norm_b = (const float*)d_in[5]; a.w_out = (const float*)d_in[6]; a.ffn_norm = (const float*)d_in[7];
    a.w_gate = (const float*)d_in[8]; a.w_up = (const float*)d_in[9]; a.w_down = (const float*)d_in[10]; a.final_norm = (const float*)d_in[11];
    a.out = (float*)d_out; a.ws = (unsigned char*)d_ws; a.ph_lo = 0; a.ph_hi = N_PHASES;
    void* args[] = {&a};
    const hipError_t e = hipLaunchCooperativeKernel((const void*)fwd_megakernel, dim3(grid), dim3(NTHREADS), args, LDS_BYTES, stream);
    if (e != hipSuccess) fprintf(stderr, "kernel_launch: cooperative launch failed: %s (grid %d)\n", hipGetErrorString(e), grid);
}
```

```cpp
#include <hip/hip_runtime.h>
#include <hip/hip_cooperative_groups.h>
#include <cstdio>
#include <cstdint>
namespace cg = cooperative_groups;
namespace pg8 {
#define PG8_LAS __attribute__((address_space(3)))
typedef unsigned short bf16_t;
typedef short bf16x8 __attribute__((ext_vector_type(8)));
typedef float f32x4 __attribute__((ext_vector_type(4)));
typedef unsigned u32x4 __attribute__((ext_vector_type(4)));
constexpr int BM = 256, BK = 64, HALF = 128, HTB = HALF * BK * 2  , STAGE_BYTES = 8 * HTB, NXCD = 8, WGM = 8;

__host__ __device__ __forceinline__ int lds_byte(int r, int c) { const int st = (r >> 4) * 2 + (c >> 5), rr = r & 15, cc = c & 31, ob = rr * 64 + cc * 2; return st * 1024 + (ob ^ (((ob >> 9) & 1) << 5)); }
__host__ __device__ __forceinline__ void stage_rc(int b, int& R, int& C) { const int st = b / 1024, sb = b % 1024, swz = sb ^ (((sb >> 9) & 1) << 5); R = (st >> 1) * 16 + swz / 64; C = (st & 1) * 32 + (swz % 64) / 2; }
__host__ __device__ __forceinline__ int perm32(int rho) { const int n = rho >> 4, i = rho & 15; return 8 * (i >> 2) + 4 * n + (i & 3); }

struct Unit { int pm, pn; };
struct Gemm { const bf16_t* A; const bf16_t* Bt; int M, N, K; };

struct StaticOrder {
    int nM, nN, nwg, G, c;
    __host__ __device__ void init(int M, int N, int G_, int c_) { nM = M / BM; nN = N / BM; nwg = nM * nN; G = G_; c = c_; }
    __host__ __device__ bool next(int i, Unit& u) const {
        const long L = (long)i * G + c; if (L >= nwg) return false;
        int wgid = (int)L; { const int q = nwg / NXCD, r = nwg % NXCD, xcd = wgid % NXCD, off = wgid / NXCD; wgid = (xcd < r ? xcd * (q + 1) : r * (q + 1) + (xcd - r) * q) + off; }
        const int nig = WGM * nN, gid = wgid / nig, fm = gid * WGM, gsz = (nM - fm) < WGM ? (nM - fm) : WGM;
        u.pm = fm + ((wgid % nig) % gsz); u.pn = (wgid % nig) / gsz; return true;
    }
    __device__ __forceinline__ void a_ready(const Unit&) const {}
    __device__ __forceinline__ void done(const Unit&) const {}
};

__device__ __forceinline__ unsigned cvt_pk_bf16(float lo, float hi) { unsigned r; asm volatile("v_cvt_pk_bf16_f32 %0, %1, %2" : "=v"(r) : "v"(lo), "v"(hi)); return r; }
typedef float f32x2 __attribute__((ext_vector_type(2)));
template <class Epi, class Sched, bool ALIGN_EPI = false, bool SP2 = false>
__device__ __forceinline__ void gemm_phase(PG8_LAS unsigned char* lds, const Gemm g, const Sched& S, const Epi& E) {
    int tid_l = threadIdx.x; asm volatile("" : "+v"(tid_l));
    const int tid = tid_l, wid = __builtin_amdgcn_readfirstlane(tid >> 6), lane = tid & 63, wr = wid >> 2, wc = wid & 3, fr = lane & 15, fq = lane >> 4;
    const int K = g.K, nt = K / BK;
    unsigned voffA[2], voffB[2];
#pragma unroll
    for (int i = 0; i < 2; ++i) { int R, C; stage_rc(tid * 16 + i * 8192, R, C); const int Rb = Epi::PERM ? ((R & ~31) + perm32(R & 31)) : R;
        voffA[i] = (unsigned)(R * K + C) * 2u; voffB[i] = (unsigned)(Rb * K + C) * 2u; }
    const size_t kstep = (size_t)(BK * 2);
    const size_t hstep = (size_t)HALF * K * 2;
    const size_t tstep = 2 * hstep;
    const unsigned ldsw = (unsigned)wid * 1024u;
    const int aoff = lds_byte(wr * 64 + fr, fq * 8), boff = lds_byte(wc * 32 + fr, fq * 8);
#define PG8_SA(b, h) (((b) * 2 + (h)) * HTB)
#define PG8_SB(b, h) ((4 + (b) * 2 + (h)) * HTB)
#define PG8_STAGE(bufoff, gbase, voff) do { _Pragma("unroll") for (int _i = 0; _i < 2; ++_i) \
        __builtin_amdgcn_global_load_lds((const unsigned*)((const char*)(gbase) + (voff)[_i]), (PG8_LAS unsigned*)(lds + (bufoff) + ldsw + _i * 8192), 16, 0, 0); } while (0)
#define PG8_LDA(dst, b, h) do { _Pragma("unroll") for (int m = 0; m < 4; ++m) _Pragma("unroll") for (int k = 0; k < 2; ++k) dst[m][k] = *(const PG8_LAS bf16x8*)(lds + PG8_SA(b, h) + aoff + m * 2048 + k * 1024); } while (0)
#define PG8_LDB(dst, b, h) do { _Pragma("unroll") for (int n = 0; n < 2; ++n) _Pragma("unroll") for (int k = 0; k < 2; ++k) dst[n][k] = *(const PG8_LAS bf16x8*)(lds + PG8_SB(b, h) + boff + n * 2048 + k * 1024); } while (0)
#define PG8_MMA(ai, bj, At, Bt) do { __builtin_amdgcn_s_setprio(1); _Pragma("unroll") for (int m = 0; m < 4; ++m) _Pragma("unroll") for (int n = 0; n < 2; ++n) _Pragma("unroll") for (int k = 0; k < 2; ++k) \
        acc[ai][bj][m][n] = __builtin_amdgcn_mfma_f32_16x16x32_bf16(Bt[n][k], At[m][k], acc[ai][bj][m][n], 0, 0, 0); __builtin_amdgcn_s_setprio(0); } while (0)
#define PG8_WAIT_V(n) asm volatile("s_waitcnt vmcnt(" #n ")" ::: "memory")
#define PG8_WAIT_L(n) asm volatile("s_waitcnt lgkmcnt(" #n ")" ::: "memory")
#define PG8_BAR __builtin_amdgcn_s_barrier()
#define PG8_SCHED __builtin_amdgcn_sched_barrier(0)
    Unit cur, nxt; int ui = 0;
    if (!S.next(0, cur)) return;
    f32x4 acc[2][2][4][2];
#pragma unroll
    for (int a = 0; a < 2; ++a)
#pragma unroll
        for (int b = 0; b < 2; ++b)
#pragma unroll
            for (int m = 0; m < 4; ++m)
#pragma unroll
                for (int n = 0; n < 2; ++n) acc[a][b][m][n] = (f32x4){0.f, 0.f, 0.f, 0.f};
    bf16x8 At[4][2], B0[2][2], B1[2][2];
    const char* cA = (const char*)g.A + (size_t)cur.pm * tstep; const char* cB = (const char*)g.Bt + (size_t)cur.pn * tstep;
    S.a_ready(cur);
    if constexpr (SP2) {
        PG8_STAGE(PG8_SB(0, 0), cB, voffB); PG8_STAGE(PG8_SB(0, 1), cB + hstep, voffB); PG8_STAGE(PG8_SA(0, 0), cA, voffA); PG8_STAGE(PG8_SA(0, 1), cA + hstep, voffA);
        if (wr == 1) PG8_BAR;
        PG8_WAIT_V(2); PG8_BAR;
        PG8_STAGE(PG8_SB(1, 0), cB + kstep, voffB); PG8_STAGE(PG8_SA(1, 0), cA + kstep, voffA); PG8_STAGE(PG8_SB(1, 1), cB + hstep + kstep, voffB);
        PG8_WAIT_V(6); PG8_BAR;
    } else {
        PG8_STAGE(PG8_SB(0, 0), cB, voffB); PG8_STAGE(PG8_SA(0, 0), cA, voffA); PG8_STAGE(PG8_SB(0, 1), cB + hstep, voffB); PG8_STAGE(PG8_SA(0, 1), cA + hstep, voffA);
        if (wr == 1) PG8_BAR;
        PG8_WAIT_V(4); PG8_BAR;
        PG8_STAGE(PG8_SB(1, 0), cB + kstep, voffB); PG8_STAGE(PG8_SA(1, 0), cA + kstep, voffA); PG8_STAGE(PG8_SB(1, 1), cB + hstep + kstep, voffB);
        PG8_WAIT_V(6); PG8_BAR;
    }
    for (;;) {
        const bool has_next = S.next(ui + 1, nxt);
        const char* nA = has_next ? (const char*)g.A + (size_t)nxt.pm * tstep : cA; const char* nB = has_next ? (const char*)g.Bt + (size_t)nxt.pn * tstep : cB;
        for (int t = 0; t < nt; t += 2) {
            const bool last = (t == nt - 2);
            const char* a1 = cA + (size_t)(t + 1) * kstep;
            const char* a2 = last ? nA : cA + (size_t)(t + 2) * kstep; const char* b2 = last ? nB : cB + (size_t)(t + 2) * kstep;
            const char* a3 = a2 + kstep; const char* b3 = b2 + kstep;
            if (last && has_next) S.a_ready(nxt);
            if constexpr (SP2) {
            PG8_LDB(B0, 0, 0); PG8_LDB(B1, 0, 1); PG8_SCHED; PG8_LDA(At, 0, 0); PG8_STAGE(PG8_SA(1, 1), a1 + hstep, voffA);
            PG8_WAIT_V(8); PG8_WAIT_L(0); PG8_BAR; PG8_MMA(0, 0, At, B0); PG8_MMA(0, 1, At, B1); PG8_BAR; PG8_SCHED;
            PG8_LDA(At, 0, 1); PG8_STAGE(PG8_SB(0, 0), b2, voffB); PG8_STAGE(PG8_SB(0, 1), b2 + hstep, voffB); PG8_STAGE(PG8_SA(0, 0), a2, voffA);
            PG8_WAIT_V(8); PG8_WAIT_L(0); PG8_BAR; PG8_MMA(1, 0, At, B0); PG8_MMA(1, 1, At, B1); PG8_BAR; PG8_SCHED;
            PG8_LDB(B0, 1, 0); PG8_LDB(B1, 1, 1); PG8_SCHED; PG8_LDA(At, 1, 0); PG8_STAGE(PG8_SA(0, 1), a2 + hstep, voffA);
            PG8_WAIT_V(8); PG8_WAIT_L(0); PG8_BAR; PG8_MMA(0, 0, At, B0); PG8_MMA(0, 1, At, B1); PG8_BAR; PG8_SCHED;
            PG8_LDA(At, 1, 1); PG8_STAGE(PG8_SB(1, 0), b3, voffB); PG8_STAGE(PG8_SB(1, 1), b3 + hstep, voffB); PG8_STAGE(PG8_SA(1, 0), a3, voffA);
            PG8_WAIT_V(8); PG8_WAIT_L(0); PG8_BAR; PG8_MMA(1, 0, At, B0); PG8_MMA(1, 1, At, B1); PG8_BAR; PG8_SCHED;
            } else {
            PG8_LDB(B0, 0, 0); PG8_SCHED; PG8_LDA(At, 0, 0); PG8_STAGE(PG8_SA(1, 1), a1 + hstep, voffA);
            PG8_WAIT_L(8); PG8_BAR; PG8_WAIT_L(0); PG8_MMA(0, 0, At, B0); PG8_BAR; PG8_SCHED;
            PG8_LDB(B1, 0, 1); PG8_STAGE(PG8_SB(0, 0), b2, voffB);
            PG8_BAR; PG8_WAIT_L(0); PG8_MMA(0, 1, At, B1); PG8_BAR;
            PG8_LDA(At, 0, 1); PG8_STAGE(PG8_SA(0, 0), a2, voffA);
            PG8_BAR; PG8_WAIT_L(0); PG8_MMA(1, 0, At, B0); PG8_BAR; PG8_SCHED;
            PG8_STAGE(PG8_SB(0, 1), b2 + hstep, voffB);
            PG8_WAIT_V(6); PG8_BAR; PG8_MMA(1, 1, At, B1); PG8_BAR;
            PG8_LDB(B0, 1, 0); PG8_SCHED; PG8_LDA(At, 1, 0); PG8_STAGE(PG8_SA(0, 1), a2 + hstep, voffA);
            PG8_WAIT_L(8); PG8_BAR; PG8_WAIT_L(0); PG8_MMA(0, 0, At, B0); PG8_BAR; PG8_SCHED;
            PG8_LDB(B1, 1, 1); PG8_STAGE(PG8_SB(1, 0), b3, voffB);
            PG8_BAR; PG8_WAIT_L(0); PG8_MMA(0, 1, At, B1); PG8_BAR;
            PG8_LDA(At, 1, 1); PG8_STAGE(PG8_SA(1, 0), a3, voffA);
            PG8_BAR; PG8_WAIT_L(0); PG8_MMA(1, 0, At, B0); PG8_BAR; PG8_SCHED;
            PG8_STAGE(PG8_SB(1, 1), b3 + hstep, voffB);
            PG8_WAIT_V(6); PG8_BAR; PG8_MMA(1, 1, At, B1); PG8_BAR;
            }
        }
        if constexpr (ALIGN_EPI) { if (wr == 0) PG8_BAR; }
        if constexpr (!Epi::AFTER_DRAIN) { E(acc, cur, wr, wc, fr, fq); S.done(cur); }
        if (!has_next) break;
#pragma unroll
        for (int a = 0; a < 2; ++a)
#pragma unroll
            for (int b = 0; b < 2; ++b)
#pragma unroll
                for (int m = 0; m < 4; ++m)
#pragma unroll
                    for (int n = 0; n < 2; ++n) acc[a][b][m][n] = (f32x4){0.f, 0.f, 0.f, 0.f};
        cur = nxt; cA = nA; cB = nB; ++ui;
        if constexpr (ALIGN_EPI) { if (wr == 1) PG8_BAR; }
    }
    PG8_WAIT_V(0);
    if constexpr (!ALIGN_EPI) { if (wr == 0) PG8_BAR; }
    PG8_BAR;
    if constexpr (Epi::AFTER_DRAIN) { E.fused(acc, cur, wr, wc, fr, fq, lds, wid, lane); S.done(cur); }
#undef PG8_SA
#undef PG8_SB
#undef PG8_STAGE
#undef PG8_LDA
#undef PG8_LDB
#undef PG8_MMA
#undef PG8_WAIT_V
#undef PG8_WAIT_L
#undef PG8_BAR
#undef PG8_SCHED
}
}

#define LAS __attribute__((address_space(3)))
typedef unsigned short bf16;
typedef unsigned v4u __attribute__((ext_vector_type(4)));
typedef unsigned v2u __attribute__((ext_vector_type(2)));
typedef float f32x4 __attribute__((ext_vector_type(4)));
typedef short bf16x8 __attribute__((ext_vector_type(8)));
typedef short v4i16_t __attribute__((ext_vector_type(4)));

constexpr int BATCH = 4, SEQ = 2048, DM = 2048, DEPTH = 4;
constexpr int T = BATCH * SEQ;
constexpr int IN_COLS = 4352, DFF = 5632, NGU = 2 * DFF;
constexpr int C_QA = 0, C_KA = 1024, C_VA = 2048, C_QB = 3072, C_KB = 4096, C_VB = 4224;
constexpr float EPS = 1e-6f, LOG2E = 1.4426950408889634f;
constexpr int NWAVES = 8, NTHREADS = 512;
constexpr int LDS_BYTES = 136 * 1024;

constexpr size_t SZ_WIN = (size_t)IN_COLS * DM * 2, SZ_WOUT = (size_t)DM * DM * 2, SZ_WGU = (size_t)NGU * DM * 2, SZ_WDN = (size_t)DM * DFF * 2;
constexpr size_t WS_WIN = 0;
constexpr size_t WS_WOUT = WS_WIN + DEPTH * SZ_WIN;
constexpr size_t WS_WGU = WS_WOUT + DEPTH * SZ_WOUT;
constexpr size_t WS_WDN = WS_WGU + DEPTH * SZ_WGU;
constexpr size_t WS_XB = WS_WDN + DEPTH * SZ_WDN;
constexpr size_t WS_PROJ = WS_XB + (size_t)T * DM * 2;
constexpr size_t WS_OA = WS_PROJ + (size_t)T * IN_COLS * 2;
constexpr size_t WS_OB = WS_OA + 3 * (size_t)T * 1024 * 2;
constexpr size_t WS_MIX = WS_OB + (size_t)T * 1024 * 2;
constexpr size_t WS_ACT = WS_MIX + (size_t)T * DM * 2;
constexpr size_t WS_SSQ = WS_ACT + (size_t)T * DFF * 2;
constexpr size_t WS_MA = WS_SSQ + (size_t)T * 32 * 4;
constexpr size_t WS_LA = WS_MA + 3 * (size_t)T * 16 * 4;
constexpr size_t WS_BAR = WS_LA + 3 * (size_t)T * 16 * 4;
constexpr size_t BAR_BYTES = 16384;
constexpr size_t WS_END = WS_BAR + BAR_BYTES;
constexpr int MISC_OFF = 135168;

#define LDS_WAIT() asm volatile("s_waitcnt lgkmcnt(0)" ::: "memory")
__device__ __forceinline__ unsigned pkbf(float lo, float hi) { return pg8::cvt_pk_bf16(lo, hi); }
__device__ __forceinline__ float wave_sum(float v) {
#pragma unroll
    for (int o = 1; o < 64; o <<= 1) v += __shfl_xor(v, o);
    return v;
}
__device__ __forceinline__ float dot4(f32x4 v) { return (v[0] * v[0] + v[1] * v[1]) + (v[2] * v[2] + v[3] * v[3]); }

__device__ __forceinline__ void rows_rstd(float (&rs)[2][4], const float* ssq, int row0, int fq) {
    f32x4 pa[2][4], pb[2][4];
#pragma unroll
    for (int ai = 0; ai < 2; ++ai)
#pragma unroll
        for (int m = 0; m < 4; ++m) { const float* p = ssq + (size_t)(row0 + ai * 128 + m * 16) * 32 + 8 * fq; pa[ai][m] = *(const f32x4*)p; pb[ai][m] = *(const f32x4*)(p + 4); }
#pragma unroll
    for (int ai = 0; ai < 2; ++ai)
#pragma unroll
        for (int m = 0; m < 4; ++m) { const f32x4 a = pa[ai][m], b = pb[ai][m];
            float s = ((a[0] + a[1]) + (a[2] + a[3])) + ((b[0] + b[1]) + (b[2] + b[3]));
            s += __shfl_xor(s, 16); s += __shfl_xor(s, 32);
            rs[ai][m] = __builtin_amdgcn_rsqf(s * (1.0f / DM) + EPS); }
}
struct EpiScaleBf16 {
    static constexpr bool PERM = true, AFTER_DRAIN = false;
    bf16* O; int ldc; const float* ssq;
    __device__ __forceinline__ void operator()(const pg8::f32x4 (&acc)[2][2][4][2], const pg8::Unit& u, int wr, int wc, int fr, int fq) const {
        const int row0 = u.pm * 256 + wr * 64 + fr, col0 = u.pn * 256 + wc * 32 + 8 * fq;
        float rs[2][4]; rows_rstd(rs, ssq, row0, fq);
#pragma unroll
        for (int ai = 0; ai < 2; ++ai)
#pragma unroll
            for (int m = 0; m < 4; ++m) {
                const int row = row0 + ai * 128 + m * 16; bf16* rowp = O + (size_t)row * ldc + col0;
#pragma unroll
                for (int bj = 0; bj < 2; ++bj) { const f32x4 v0 = acc[ai][bj][m][0] * rs[ai][m], v1 = acc[ai][bj][m][1] * rs[ai][m];
                    v4u w; w.x = pkbf(v0[0], v0[1]); w.y = pkbf(v0[2], v0[3]); w.z = pkbf(v1[0], v1[1]); w.w = pkbf(v1[2], v1[3]);
                    *(v4u*)(rowp + bj * 128) = w; }
            }
    }
};
struct EpiSwiglu {
    static constexpr bool PERM = true, AFTER_DRAIN = false;
    bf16* O; const float* ssq;
    __device__ __forceinline__ void operator()(const pg8::f32x4 (&acc)[2][2][4][2], const pg8::Unit& u, int wr, int wc, int fr, int fq) const {
        const int row0 = u.pm * 256 + wr * 64 + fr, col0 = u.pn * 128 + wc * 32 + 8 * fq;
        float rs[2][4]; rows_rstd(rs, ssq, row0, fq);
#pragma unroll
        for (int ai = 0; ai < 2; ++ai)
#pragma unroll
            for (int m = 0; m < 4; ++m) {
                const int row = row0 + ai * 128 + m * 16; const float r1 = rs[ai][m];
                float a[8];
#pragma unroll
                for (int n = 0; n < 2; ++n)
#pragma unroll
                    for (int k = 0; k < 4; ++k) { const float g = acc[ai][0][m][n][k] * r1, up = acc[ai][1][m][n][k] * r1;
                        a[n * 4 + k] = g * __builtin_amdgcn_rcpf(1.0f + __builtin_amdgcn_exp2f(-g * LOG2E)) * up; }
                v4u w; w.x = pkbf(a[0], a[1]); w.y = pkbf(a[2], a[3]); w.z = pkbf(a[4], a[5]); w.w = pkbf(a[6], a[7]);
                *(v4u*)(O + (size_t)row * DFF + col0) = w;
            }
    }
};
struct EpiResid {
    static constexpr bool PERM = false, AFTER_DRAIN = false;
    bf16* xb; float* ssq;
    __device__ __forceinline__ void operator()(const pg8::f32x4 (&acc)[2][2][4][2], const pg8::Unit& u, int wr, int wc, int fr, int fq) const {
        const int row0 = u.pm * 256 + wr * 64 + fr, col0 = u.pn * 256 + wc * 32 + 4 * fq;
        v2u xv[2][4][2][2];
#pragma unroll
        for (int ai = 0; ai < 2; ++ai)
#pragma unroll
            for (int m = 0; m < 4; ++m) { const bf16* br = xb + (size_t)(row0 + ai * 128 + m * 16) * DM + col0;
#pragma unroll
                for (int bj = 0; bj < 2; ++bj)
#pragma unroll
                    for (int n = 0; n < 2; ++n) xv[ai][m][bj][n] = *(const v2u*)(br + bj * 128 + n * 16); }
#pragma unroll
        for (int ai = 0; ai < 2; ++ai)
#pragma unroll
            for (int m = 0; m < 4; ++m) {
                const int row = row0 + ai * 128 + m * 16; bf16* br = xb + (size_t)row * DM + col0; float ss = 0.f;
#pragma unroll
                for (int bj = 0; bj < 2; ++bj)
#pragma unroll
                    for (int n = 0; n < 2; ++n) { const int off = bj * 128 + n * 16; const v2u q = xv[ai][m][bj][n];
                        const f32x4 xo = {__uint_as_float(q.x << 16), __uint_as_float(q.x & 0xffff0000u), __uint_as_float(q.y << 16), __uint_as_float(q.y & 0xffff0000u)};
                        const f32x4 v = xo + acc[ai][bj][m][n];
                        v2u w; w.x = pkbf(v[0], v[1]); w.y = pkbf(v[2], v[3]); *(v2u*)(br + off) = w; ss += dot4(v); }
                ss += __shfl_xor(ss, 16); ss += __shfl_xor(ss, 32);
                if (fq == 0) ssq[(size_t)row * 32 + u.pn * 4 + wc] = ss;
            }
    }
};

__device__ __forceinline__ void p0_item(const float* __restrict__ W, int K, int N, bf16* WT, const float* g, int mode, LAS float* scr, int item, int lane) {
    const int nblk = N >> 6, kb = item / nblk, nb = item - kb * nblk, k0 = kb << 6, n0 = nb << 6;
    f32x4 v[16];
    const float* src = W + (size_t)(k0 + (lane >> 4)) * N + n0 + 4 * (lane & 15);
#pragma unroll
    for (int i = 0; i < 16; ++i) v[i] = *(const f32x4*)(src + (size_t)(4 * i) * N);
#pragma unroll
    for (int i = 0; i < 16; ++i) { LAS float* d = scr + (4 * i + (lane >> 4)) * 65 + 4 * (lane & 15); d[0] = v[i][0]; d[1] = v[i][1]; d[2] = v[i][2]; d[3] = v[i][3]; }
    LDS_WAIT();
    const int c = lane & 7;
    f32x4 g0 = {1.f, 1.f, 1.f, 1.f}, g1 = {1.f, 1.f, 1.f, 1.f};
    if (g) { g0 = *(const f32x4*)(g + k0 + 8 * c); g1 = *(const f32x4*)(g + k0 + 8 * c + 4); }
#pragma unroll
    for (int j = 0; j < 8; ++j) {
        const int n = (lane >> 3) + 8 * j; const LAS float* s = scr + (8 * c) * 65 + n;
        v4u o; o.x = pkbf(s[0] * g0[0], s[65] * g0[1]); o.y = pkbf(s[130] * g0[2], s[195] * g0[3]); o.z = pkbf(s[260] * g1[0], s[325] * g1[1]); o.w = pkbf(s[390] * g1[2], s[455] * g1[3]);
        const int nn = n0 + n; const int row = (mode == 0) ? nn : (((nn >> 7) << 8) + (nn & 127) + (mode == 2 ? 128 : 0));
        *(v4u*)(WT + (size_t)row * K + k0 + 8 * c) = o;
    }
    LDS_WAIT();
}

struct Args {
    const float* x; const float* attn_norm; const float* w_in; const float* sinks; const float* out_norm_a; const float* out_norm_b;
    const float* w_out; const float* ffn_norm; const float* w_gate; const float* w_up; const float* w_down; const float* final_norm;
    float* out; unsigned char* ws; int ph_lo, ph_hi;
};

constexpr int I_IN = (DM / 64) * (IN_COLS / 64), I_OUT = (DM / 64) * (DM / 64), I_G = (DM / 64) * (DFF / 64), I_D = (DFF / 64) * (DM / 64);
constexpr int I_FRONT = I_IN + I_OUT + I_G, I_LAYER = I_FRONT + I_G + I_D;
__device__ __forceinline__ void p0_layer_items(const Args& a, int l, int lo, int hi, int ww, int nww, LAS unsigned char* lds, int wave, int lane) {
    LAS float* scr = (LAS float*)(lds + wave * 16640);
    for (int it = lo + ww; it < hi; it += nww) {
        int r = it;
        if (r < I_IN) { p0_item(a.w_in + (size_t)l * DM * IN_COLS, DM, IN_COLS, (bf16*)(a.ws + WS_WIN + l * SZ_WIN), a.attn_norm + l * DM, 0, scr, r, lane); continue; } r -= I_IN;
        if (r < I_OUT) { p0_item(a.w_out + (size_t)l * DM * DM, DM, DM, (bf16*)(a.ws + WS_WOUT + l * SZ_WOUT), nullptr, 0, scr, r, lane); continue; } r -= I_OUT;
        if (r < I_G) { p0_item(a.w_gate + (size_t)l * DM * DFF, DM, DFF, (bf16*)(a.ws + WS_WGU + l * SZ_WGU), a.ffn_norm + l * DM, 1, scr, r, lane); continue; } r -= I_G;
        if (r < I_G) { p0_item(a.w_up + (size_t)l * DM * DFF, DM, DFF, (bf16*)(a.ws + WS_WGU + l * SZ_WGU), a.ffn_norm + l * DM, 2, scr, r, lane); continue; } r -= I_G;
        p0_item(a.w_down + (size_t)l * DFF * DM, DFF, DM, (bf16*)(a.ws + WS_WDN + l * SZ_WDN), nullptr, 0, scr, r, lane);
    }
}
__device__ __forceinline__ void p0_in_tail(const Args& a, int l, int lo, int hi, int nunits, LAS unsigned char* lds, int wave, int lane) {
    const int G = (int)gridDim.x, busy = nunits - ((nunits - 1) / G) * G;
    if (busy >= G) p0_layer_items(a, l, lo, hi, (int)blockIdx.x * NWAVES + wave, G * NWAVES, lds, wave, lane);
    else if ((int)blockIdx.x >= busy) p0_layer_items(a, l, lo, hi, ((int)blockIdx.x - busy) * NWAVES + wave, (G - busy) * NWAVES, lds, wave, lane);
}
__device__ __forceinline__ void p0_phase(const Args& a, LAS unsigned char* lds, int wave, int lane) {
    const int gw = blockIdx.x * NWAVES + wave, NGW = gridDim.x * NWAVES;
    p0_layer_items(a, 0, 0, I_LAYER, gw, NGW, lds, wave, lane);
    bf16* xb = (bf16*)(a.ws + WS_XB); float* ssq = (float*)(a.ws + WS_SSQ);
    for (int m = gw; m < T; m += NGW) {
        const f32x4* xr = (const f32x4*)(a.x + (size_t)m * DM) + lane; f32x4 v[8]; float ss = 0.f;
#pragma unroll
        for (int j = 0; j < 8; ++j) { v[j] = xr[64 * j]; ss += dot4(v[j]); }
        ss = wave_sum(ss);
        v2u* brow = (v2u*)(xb + (size_t)m * DM) + lane;
#pragma unroll
        for (int j = 0; j < 8; ++j) { v2u w; w.x = pkbf(v[j][0], v[j][1]); w.y = pkbf(v[j][2], v[j][3]); brow[64 * j] = w; }
        if (lane < 32) ssq[(size_t)m * 32 + lane] = (lane == 0) ? ss : 0.f;
    }
}

constexpr int KV_PITCH = 144, KV_ROWS = 272, LDS_KOFF = 0, LDS_VOFF = KV_ROWS * KV_PITCH;
constexpr int N_UNITS_A = 3 * 1024, N_UNITS = N_UNITS_A + 1024;
__device__ __forceinline__ v4i16_t vtr(const LAS unsigned char* p) { return __builtin_amdgcn_ds_read_tr16_b64_v4i16((LAS v4i16_t*)p); }

struct AU { int d, b, r, qt, qcol, kcol, vcol, br, hh; };
__device__ __forceinline__ void au_decode(int idx, AU& u) {
    if (idx < N_UNITS_A) {
        u.br = idx >> 10; const int rem = idx & 1023; u.d = (u.br == 0) ? 1 : (u.br == 1 ? 4 : 16);
        u.b = rem >> 8; u.hh = (rem >> 4) & 15; const int nqt = 16 / u.d, w16 = rem & 15; u.r = w16 / nqt; u.qt = w16 - u.r * nqt;
        u.qcol = C_QA + u.hh * 64; u.kcol = C_KA + u.hh * 64; u.vcol = C_VA + u.hh * 64;
    } else {
        u.br = 3; const int rem = idx - N_UNITS_A; u.d = 1; u.r = 0;
        u.b = rem >> 8; const int g = (rem >> 7) & 1, rr = (rem >> 4) & 7; u.qt = rem & 15; u.hh = g * 8 + rr;
        u.qcol = C_QB + u.hh * 64; u.kcol = C_KB + g * 64; u.vcol = C_VB + g * 64;
    }
}
__device__ __forceinline__ void au_load(const bf16* __restrict__ proj, const float* sinks_l, const AU& u, int tid, int wave, int lane, v4u (&kr)[4], v4u (&vr)[4], bf16x8& q0, bf16x8& q1, float& sink) {
    const int c8 = tid & 7, r0 = tid >> 3;
#pragma unroll
    for (int i = 0; i < 4; ++i) {
        const int row = r0 + 64 * i; int ks = 128 * u.qt - 128 + row; ks = ks < 0 ? 0 : ks;
        const bf16* p = proj + (size_t)(u.b * SEQ + u.r + u.d * ks) * IN_COLS + 8 * c8; kr[i] = *(const v4u*)(p + u.kcol); vr[i] = *(const v4u*)(p + u.vcol);
    }
    const int iq = 128 * u.qt + 16 * wave + (lane & 15);
    const bf16* qp = proj + (size_t)(u.b * SEQ + u.r + u.d * iq) * IN_COLS + u.qcol + 8 * (lane >> 4);
    q0 = *(const bf16x8*)qp; q1 = *(const bf16x8*)(qp + 32);
    sink = sinks_l[u.hh];
}

__device__ __forceinline__ void attn_compute(LAS unsigned char* lds, const AU& u, const bf16x8 q0, const bf16x8 q1, const float sink,
                                             bf16* oA, bf16* oB, float* mA, float* lA, int wave, int lane) {
    const int d = u.d, qt = u.qt, br = u.br, hh = u.hh;
    float slope, maxd, sink_l2 = 0.f;
    if (br < 3) { slope = __builtin_amdgcn_exp2f(-(float)(2 * hh + 1) * 0.25f); maxd = 128.f; }
    else { slope = __builtin_amdgcn_exp2f(-(float)(hh + 1) * 0.5f); maxd = 127.f; sink_l2 = sink * LOG2E; }
    const float sl2 = slope * (float)d * LOG2E;
    const float C2 = 0.125f * LOG2E;
    const int fr = lane & 15, fq = lane >> 4;
    const int iq = 128 * qt + 16 * wave + fr;
    const size_t grow = (size_t)(u.b * SEQ + u.r + d * iq);
    f32x4 sc[9];
    {
        const LAS unsigned char* kb = lds + LDS_KOFF + (16 * wave + fr) * KV_PITCH + 16 * fq;
#pragma unroll
        for (int j = 0; j < 9; ++j) {
            const bf16x8 k0 = *(const LAS bf16x8*)(kb + j * 16 * KV_PITCH), k1 = *(const LAS bf16x8*)(kb + j * 16 * KV_PITCH + 64);
            f32x4 z = {0.f, 0.f, 0.f, 0.f};
            z = __builtin_amdgcn_mfma_f32_16x16x32_bf16(k0, q0, z, 0, 0, 0);
            sc[j] = __builtin_amdgcn_mfma_f32_16x16x32_bf16(k1, q1, z, 0, 0, 0);
        }
    }
    const float bl = (float)(fr - 4 * fq);
    const bool early = (qt == 0);
    float mx = -INFINITY;
#pragma unroll
    for (int j = 0; j < 9; ++j)
#pragma unroll
        for (int jj = 0; jj < 4; ++jj) {
            const float dist = (float)(128 - 16 * j - jj) + bl;
            float v = __builtin_fmaf(sc[j][jj], C2, -sl2 * dist);
            bool ok = true;
            if (j == 0) ok = dist <= maxd;
            if (j == 8) ok = dist >= 0.f;
            if (early && (wave + j < 8)) ok = false;
            v = ok ? v : -INFINITY; sc[j][jj] = v; mx = __builtin_fmaxf(mx, v);
        }
    mx = __builtin_fmaxf(mx, __shfl_xor(mx, 16)); mx = __builtin_fmaxf(mx, __shfl_xor(mx, 32));
    float lsum = 0.f;
#pragma unroll
    for (int j = 0; j < 9; ++j)
#pragma unroll
        for (int jj = 0; jj < 4; ++jj) { const float p = __builtin_amdgcn_exp2f(sc[j][jj] - mx); sc[j][jj] = p; lsum += p; }
    lsum += __shfl_xor(lsum, 16); lsum += __shfl_xor(lsum, 32);
    f32x4 o[4];
#pragma unroll
    for (int dt = 0; dt < 4; ++dt) o[dt] = (f32x4){0.f, 0.f, 0.f, 0.f};
    {
        const int q4 = (lane & 15) >> 2, p4 = lane & 3;
        const LAS unsigned char* vb = lds + LDS_VOFF + (16 * wave + 4 * fq + q4) * KV_PITCH + 8 * p4;
#pragma unroll
        for (int c = 0; c < 5; ++c) {
            v4u yw; yw.x = pkbf(sc[2 * c][0], sc[2 * c][1]); yw.y = pkbf(sc[2 * c][2], sc[2 * c][3]);
            if (c < 4) { yw.z = pkbf(sc[(c < 4) ? 2 * c + 1 : 0][0], sc[(c < 4) ? 2 * c + 1 : 0][1]); yw.w = pkbf(sc[(c < 4) ? 2 * c + 1 : 0][2], sc[(c < 4) ? 2 * c + 1 : 0][3]); }
            else { yw.z = 0u; yw.w = 0u; }
            const bf16x8 Y = __builtin_bit_cast(bf16x8, yw);
#pragma unroll
            for (int dt = 0; dt < 4; ++dt) {
                const v4i16_t lo = vtr(vb + (32 * c) * KV_PITCH + 32 * dt), hi = vtr(vb + (32 * c + 16) * KV_PITCH + 32 * dt);
                const bf16x8 X = {lo[0], lo[1], lo[2], lo[3], hi[0], hi[1], hi[2], hi[3]};
                o[dt] = __builtin_amdgcn_mfma_f32_16x16x32_bf16(X, Y, o[dt], 0, 0, 0);
            }
        }
    }
    float inv; bf16* op;
    if (br < 3) {
        inv = __builtin_amdgcn_rcpf(lsum);
        if (fq == 0) { mA[((size_t)br * T + grow) * 16 + hh] = mx; lA[((size_t)br * T + grow) * 16 + hh] = lsum; }
        op = oA + ((size_t)br * T + grow) * 1024 + hh * 64 + 4 * fq;
    } else {
        const float m2 = __builtin_fmaxf(mx, sink_l2), cf = __builtin_amdgcn_exp2f(mx - m2);
        inv = cf * __builtin_amdgcn_rcpf(lsum * cf + __builtin_amdgcn_exp2f(sink_l2 - m2));
        op = oB + grow * 1024 + hh * 64 + 4 * fq;
    }
#pragma unroll
    for (int dt = 0; dt < 4; ++dt) { v2u w; w.x = pkbf(o[dt][0] * inv, o[dt][1] * inv); w.y = pkbf(o[dt][2] * inv, o[dt][3] * inv); *(v2u*)(op + 16 * dt) = w; }
}

__device__ __forceinline__ void attn_phase(LAS unsigned char* lds, const bf16* __restrict__ proj, const float* sinks_l,
                                           bf16* oA, bf16* oB, float* mA, float* lA, int tid, int wave, int lane) {
    int idx = blockIdx.x;
    if (idx >= N_UNITS) return;
    AU cur, nxt; v4u kr[4], vr[4]; bf16x8 q0, q1; float sink;
    au_decode(idx, cur); au_load(proj, sinks_l, cur, tid, wave, lane, kr, vr, q0, q1, sink);
    const int c8 = tid & 7, r0 = tid >> 3;
    if (tid < 128) { const int row = 256 + r0; const v4u z = {0u, 0u, 0u, 0u};
        *(LAS v4u*)(lds + LDS_KOFF + row * KV_PITCH + 16 * c8) = z; *(LAS v4u*)(lds + LDS_VOFF + row * KV_PITCH + 16 * c8) = z; }
    for (;;) {
#pragma unroll
        for (int i = 0; i < 4; ++i) { const int row = r0 + 64 * i; const bool valid = (128 * cur.qt - 128 + row) >= 0; const v4u z = {0u, 0u, 0u, 0u};
            *(LAS v4u*)(lds + LDS_KOFF + row * KV_PITCH + 16 * c8) = valid ? kr[i] : z; *(LAS v4u*)(lds + LDS_VOFF + row * KV_PITCH + 16 * c8) = valid ? vr[i] : z; }
        const bf16x8 cq0 = q0, cq1 = q1; const float csink = sink;
        __syncthreads();
        const int nidx = idx + (int)gridDim.x; const bool has_next = nidx < N_UNITS;
        if (has_next) { au_decode(nidx, nxt); au_load(proj, sinks_l, nxt, tid, wave, lane, kr, vr, q0, q1, sink); }
        attn_compute(lds, cur, cq0, cq1, csink, oA, oB, mA, lA, wave, lane);
        __syncthreads();
        if (!has_next) break;
        cur = nxt; idx = nidx;
    }
}

__device__ __forceinline__ void merge_phase(const Args& a, int layer, int wave, int lane) {
    const bf16* oA = (const bf16*)(a.ws + WS_OA); const bf16* oB = (const bf16*)(a.ws + WS_OB);
    const float* mA = (const float*)(a.ws + WS_MA); const float* lA = (const float*)(a.ws + WS_LA);
    bf16* mix = (bf16*)(a.ws + WS_MIX);
    const float* gA = a.out_norm_a + layer * 1024 + lane * 16; const float* gB = a.out_norm_b + layer * 1024 + lane * 16;
    const int gw = blockIdx.x * NWAVES + wave, NGW = gridDim.x * NWAVES, ha = lane >> 2;
    for (int t = gw; t < T; t += NGW) {
        float wgt[3]; float mxx = -INFINITY;
#pragma unroll
        for (int i = 0; i < 3; ++i) { wgt[i] = mA[((size_t)i * T + t) * 16 + ha]; mxx = __builtin_fmaxf(mxx, wgt[i]); }
        float wsum = 0.f;
#pragma unroll
        for (int i = 0; i < 3; ++i) { wgt[i] = __builtin_amdgcn_exp2f(wgt[i] - mxx) * lA[((size_t)i * T + t) * 16 + ha]; wsum += wgt[i]; }
        const float winv = 1.0f / wsum;
        float acc[16];
#pragma unroll
        for (int k = 0; k < 16; ++k) acc[k] = 0.f;
#pragma unroll
        for (int i = 0; i < 3; ++i) {
            const v4u* p = (const v4u*)(oA + ((size_t)i * T + t) * 1024 + lane * 16); const float wi = wgt[i] * winv;
#pragma unroll
            for (int h2 = 0; h2 < 2; ++h2) { const v4u q = p[h2];
#pragma unroll
                for (int k = 0; k < 4; ++k) { acc[h2 * 8 + 2 * k] += wi * __uint_as_float(q[k] << 16); acc[h2 * 8 + 2 * k + 1] += wi * __uint_as_float(q[k] & 0xffff0000u); } }
        }
        float ss = 0.f;
#pragma unroll
        for (int k = 0; k < 16; ++k) ss += acc[k] * acc[k];
        ss = wave_sum(ss);
        float rs = __builtin_amdgcn_rsqf(ss * (1.0f / 1024.f) + EPS);
        {
            v4u o0, o1; const f32x4 g0 = *(const f32x4*)(gA), g1 = *(const f32x4*)(gA + 4), g2 = *(const f32x4*)(gA + 8), g3 = *(const f32x4*)(gA + 12);
            o0.x = pkbf(acc[0] * rs * g0[0], acc[1] * rs * g0[1]); o0.y = pkbf(acc[2] * rs * g0[2], acc[3] * rs * g0[3]);
            o0.z = pkbf(acc[4] * rs * g1[0], acc[5] * rs * g1[1]); o0.w = pkbf(acc[6] * rs * g1[2], acc[7] * rs * g1[3]);
            o1.x = pkbf(acc[8] * rs * g2[0], acc[9] * rs * g2[1]); o1.y = pkbf(acc[10] * rs * g2[2], acc[11] * rs * g2[3]);
            o1.z = pkbf(acc[12] * rs * g3[0], acc[13] * rs * g3[1]); o1.w = pkbf(acc[14] * rs * g3[2], acc[15] * rs * g3[3]);
            v4u* mp = (v4u*)(mix + (size_t)t * DM + lane * 16); mp[0] = o0; mp[1] = o1;
        }
        {
            const v4u* p = (const v4u*)(oB + (size_t)t * 1024 + lane * 16);
#pragma unroll
            for (int h2 = 0; h2 < 2; ++h2) { const v4u q = p[h2];
#pragma unroll
                for (int k = 0; k < 4; ++k) { acc[h2 * 8 + 2 * k] = __uint_as_float(q[k] << 16); acc[h2 * 8 + 2 * k + 1] = __uint_as_float(q[k] & 0xffff0000u); } }
            ss = 0.f;
#pragma unroll
            for (int k = 0; k < 16; ++k) ss += acc[k] * acc[k];
            ss = wave_sum(ss);
            rs = __builtin_amdgcn_rsqf(ss * (1.0f / 1024.f) + EPS);
            v4u o0, o1; const f32x4 g0 = *(const f32x4*)(gB), g1 = *(const f32x4*)(gB + 4), g2 = *(const f32x4*)(gB + 8), g3 = *(const f32x4*)(gB + 12);
            o0.x = pkbf(acc[0] * rs * g0[0], acc[1] * rs * g0[1]); o0.y = pkbf(acc[2] * rs * g0[2], acc[3] * rs * g0[3]);
            o0.z = pkbf(acc[4] * rs * g1[0], acc[5] * rs * g1[1]); o0.w = pkbf(acc[6] * rs * g1[2], acc[7] * rs * g1[3]);
            o1.x = pkbf(acc[8] * rs * g2[0], acc[9] * rs * g2[1]); o1.y = pkbf(acc[10] * rs * g2[2], acc[11] * rs * g2[3]);
            o1.z = pkbf(acc[12] * rs * g3[0], acc[13] * rs * g3[1]); o1.w = pkbf(acc[14] * rs * g3[2], acc[15] * rs * g3[3]);
            v4u* mp = (v4u*)(mix + (size_t)t * DM + 1024 + lane * 16); mp[0] = o0; mp[1] = o1;
        }
    }
}

__device__ __forceinline__ void final_phase(const Args& a, int wave, int lane) {
    const int gw = blockIdx.x * NWAVES + wave, NGW = gridDim.x * NWAVES; const bf16* xb = (const bf16*)(a.ws + WS_XB);
    for (int m = gw; m < T; m += NGW) {
        const v2u* br = (const v2u*)(xb + (size_t)m * DM) + lane; f32x4* orow = (f32x4*)(a.out + (size_t)m * DM) + lane; const f32x4* gr = (const f32x4*)a.final_norm + lane; f32x4 v[8]; float ss = 0.f;
#pragma unroll
        for (int j = 0; j < 8; ++j) { const v2u q = br[64 * j]; v[j] = (f32x4){__uint_as_float(q.x << 16), __uint_as_float(q.x & 0xffff0000u), __uint_as_float(q.y << 16), __uint_as_float(q.y & 0xffff0000u)}; ss += dot4(v[j]); }
        ss = wave_sum(ss);
        const float rs = __builtin_amdgcn_rsqf(ss * (1.0f / DM) + EPS);
#pragma unroll
        for (int j = 0; j < 8; ++j) orow[64 * j] = v[j] * rs * gr[64 * j];
    }
}

#define RLX_AGENT __ATOMIC_RELAXED, __HIP_MEMORY_SCOPE_AGENT
#define XB_TMO      128
#define XB_XCNT(j)  (256  + 64 * (j))
#define XB_XSUB(j)  (1280 + 64 * (j))
#define XB_XGEN(j)  (2304 + 64 * (j))
#define XB_TOP      3328
#define XB_TOPGEN   3392
#define XCD_BAR_WORDS 3456
#define XB_SPIN_CAP (1u << 18)

__device__ __forceinline__ unsigned xb_ld(unsigned* p)              { return __hip_atomic_load(p, __ATOMIC_RELAXED, __HIP_MEMORY_SCOPE_AGENT); }
__device__ __forceinline__ unsigned xb_add(unsigned* p, unsigned v) { return __hip_atomic_fetch_add(p, v, __ATOMIC_RELAXED, __HIP_MEMORY_SCOPE_AGENT); }
__device__ __forceinline__ unsigned xb_xcc_id() { return (unsigned)__builtin_amdgcn_s_getreg((3 << 11) | 20) & 0xFu; }
#define XB_SPIN(cond, bar) do { unsigned _sp = 0; while (cond) { __builtin_amdgcn_s_sleep(1); \
    if ((++_sp & 255u) == 0u) { if (xb_ld(&(bar)[XB_TMO])) break; if (_sp > XB_SPIN_CAP) { atomicAdd(&(bar)[XB_TMO], 1u); break; } } } } while (0)

struct XcdBarrier {
    unsigned* bar; unsigned x;
    volatile LAS unsigned* st;
};

__device__ __forceinline__ XcdBarrier xcd_barrier_post(unsigned* bar, volatile LAS unsigned* st) {
    XcdBarrier b; b.bar = bar; b.x = xb_xcc_id(); b.st = st;
    if (threadIdx.x == 0) (void)xb_add(&bar[XB_XCNT(b.x)], 1u);
    return b;
}
__device__ __forceinline__ void xcd_barrier_complete(unsigned* bar, unsigned x, unsigned& nloc, unsigned& nx) {
    const unsigned G = gridDim.x * gridDim.y * gridDim.z;
    unsigned sum, cnt, mine, sp = 0u;
    for (;;) {
        sum = 0u; cnt = 0u; mine = 0u;
#pragma unroll
        for (unsigned j = 0; j < 16; ++j) { const unsigned c = xb_ld(&bar[XB_XCNT(j)]); sum += c; cnt += (c > 0u) ? 1u : 0u; mine = (j == x) ? c : mine; }
        if (sum == G) break;
        __builtin_amdgcn_s_sleep(1);
        if ((++sp & 255u) == 0u) { if (xb_ld(&bar[XB_TMO])) break; if (sp > XB_SPIN_CAP) { atomicAdd(&bar[XB_TMO], 1u); break; } }
    }
    nloc = mine > 0u ? mine : 1u; nx = cnt > 0u ? cnt : 1u;
}

__device__ __forceinline__ void xcd_barrier(const XcdBarrier& b) {
    asm volatile("s_waitcnt vmcnt(0)" ::: "memory");
    __syncthreads();
    if (threadIdx.x == 0) {
        unsigned* bar = b.bar;
        __builtin_amdgcn_s_waitcnt(0);
        unsigned nloc = b.st[0], nx = b.st[1];
        if (nloc == 0u) { xcd_barrier_complete(bar, b.x, nloc, nx); b.st[0] = nloc; b.st[1] = nx; }
        const unsigned old = xb_add(&bar[XB_XSUB(b.x)], 1u);
        const unsigned gen = old / nloc;
        if (old + 1u == (gen + 1u) * nloc) {
            __builtin_amdgcn_fence(__ATOMIC_RELEASE, "agent");
            asm volatile("s_waitcnt vmcnt(0)" ::: "memory");
            const unsigned og = xb_add(&bar[XB_TOP], 1u);
            const unsigned tg = og / nx;
            if (og + 1u == (tg + 1u) * nx) xb_add(&bar[XB_TOPGEN], 1u);
            else XB_SPIN(xb_ld(&bar[XB_TOPGEN]) == tg, bar);
            __builtin_amdgcn_fence(__ATOMIC_ACQUIRE, "agent");
            xb_add(&bar[XB_XGEN(b.x)], 1u);
            asm volatile("s_waitcnt vmcnt(0)" ::: "memory");
        } else {
            XB_SPIN(xb_ld(&bar[XB_XGEN(b.x)]) == gen, bar);
            __builtin_amdgcn_fence(__ATOMIC_ACQUIRE, "agent");
            asm volatile("s_waitcnt vmcnt(0)" ::: "memory");
        }
    }
    __syncthreads();
}

#ifndef PROBE_DUP
#define PROBE_DUP -1
#endif
#ifndef PROBE_P0
#define PROBE_P0 0
#endif
constexpr int PL = 6 + (PROBE_DUP >= 0 ? 1 : 0), PH0 = 1 + PROBE_P0;
constexpr int N_PHASES = PH0 + 1 + PL * DEPTH;
__global__ void __launch_bounds__(NTHREADS, 2) fwd_megakernel(Args a) {
    extern __shared__ __attribute__((aligned(16))) unsigned char lds_raw[];
    cg::grid_group grid = cg::this_grid();
    LAS unsigned char* lds = (LAS unsigned char*)lds_raw;
    bf16* xb = (bf16*)(a.ws + WS_XB); bf16* proj = (bf16*)(a.ws + WS_PROJ); bf16* mix = (bf16*)(a.ws + WS_MIX); bf16* act = (bf16*)(a.ws + WS_ACT);
    float* ssq = (float*)(a.ws + WS_SSQ);
    volatile LAS unsigned* MISC = (volatile LAS unsigned*)(lds + MISC_OFF);
    if (threadIdx.x < 32) MISC[threadIdx.x] = 0u;
    __syncthreads();
    XcdBarrier bar = xcd_barrier_post((unsigned*)(a.ws + WS_BAR), MISC + 8);
    for (int ph = a.ph_lo; ph < a.ph_hi; ++ph) {
        int tid_l = threadIdx.x; asm volatile("" : "+v"(tid_l));
        const int tid = tid_l, lane = tid & 63, wave = __builtin_amdgcn_readfirstlane(tid >> 6);
        if (ph < PH0) p0_phase(a, lds, wave, lane);
        else if (ph == N_PHASES - 1) final_phase(a, wave, lane);
        else {
            const int l = (ph - PH0) / PL, kq = (ph - PH0) - PL * l, k = (PROBE_DUP >= 0 && kq > PROBE_DUP) ? kq - 1 : kq;
            if (k == 0) {
                pg8::Gemm g{xb, (const bf16*)(a.ws + WS_WIN + l * SZ_WIN), T, IN_COLS, DM}; pg8::StaticOrder S; S.init(T, IN_COLS, (int)gridDim.x, (int)blockIdx.x);
                EpiScaleBf16 E{proj, IN_COLS, ssq};
                pg8::gemm_phase<EpiScaleBf16, pg8::StaticOrder, true, true>(lds, g, S, E);
                if (l + 1 < DEPTH) p0_in_tail(a, l + 1, 0, I_FRONT, (T / 256) * (IN_COLS / 256), lds, wave, lane);
            } else if (k == 1) {
                attn_phase(lds, proj, a.sinks + l * 16, (bf16*)(a.ws + WS_OA), (bf16*)(a.ws + WS_OB), (float*)(a.ws + WS_MA), (float*)(a.ws + WS_LA), tid, wave, lane);
            } else if (k == 2) {
                merge_phase(a, l, wave, lane);
            } else if (k == 3) {
                pg8::Gemm g{mix, (const bf16*)(a.ws + WS_WOUT + l * SZ_WOUT), T, DM, DM}; pg8::StaticOrder S; S.init(T, DM, (int)gridDim.x, (int)blockIdx.x);
                EpiResid E{xb, ssq};
                pg8::gemm_phase<EpiResid, pg8::StaticOrder, false, true>(lds, g, S, E);
            } else if (k == 4) {
                pg8::Gemm g{xb, (const bf16*)(a.ws + WS_WGU + l * SZ_WGU), T, NGU, DM}; pg8::StaticOrder S; S.init(T, NGU, (int)gridDim.x, (int)blockIdx.x);
                EpiSwiglu E{act, ssq};
                pg8::gemm_phase<EpiSwiglu, pg8::StaticOrder, true, true>(lds, g, S, E);
                if (l + 1 < DEPTH) p0_in_tail(a, l + 1, I_FRONT, I_LAYER, (T / 256) * (NGU / 256), lds, wave, lane);
            } else {
                pg8::Gemm g{act, (const bf16*)(a.ws + WS_WDN + l * SZ_WDN), T, DM, DFF}; pg8::StaticOrder S; S.init(T, DM, (int)gridDim.x, (int)blockIdx.x);
                EpiResid E{xb, ssq};
                pg8::gemm_phase<EpiResid, pg8::StaticOrder, false, true>(lds, g, S, E);
            }
        }
        if (ph + 1 < a.ph_hi) { if (ph == 0) grid.sync(); else xcd_barrier(bar); }
    }
}

extern "C" void kernel_launch(void* const* d_in, const int* in_sizes, int n_in, void* d_out, int out_size, void* d_ws, size_t ws_size, hipStream_t stream) {
    static int grid = 0;
    if (grid == 0) {
        if (n_in != 12 || in_sizes[0] != T * DM || out_size != T * DM || ws_size < WS_END) { fprintf(stderr, "kernel_launch: unexpected shapes (n_in %d, out %d, ws %zu < %zu)\n", n_in, out_size, ws_size, (size_t)WS_END); grid = -1; return; }
        int dev = 0, cus = 0, per_cu = 0;
        if (hipGetDevice(&dev) != hipSuccess || hipDeviceGetAttribute(&cus, hipDeviceAttributeMultiprocessorCount, dev) != hipSuccess) { grid = -1; return; }
        if (hipFuncSetAttribute((const void*)fwd_megakernel, hipFuncAttributeMaxDynamicSharedMemorySize, LDS_BYTES) != hipSuccess) { fprintf(stderr, "kernel_launch: hipFuncSetAttribute failed\n"); grid = -1; return; }
        if (hipOccupancyMaxActiveBlocksPerMultiprocessor(&per_cu, (const void*)fwd_megakernel, NTHREADS, LDS_BYTES) != hipSuccess || per_cu < 1) per_cu = 1;
        (void)hipGetLastError();
        grid = cus * per_cu;
    }
    if (grid < 0) return;
    if (hipMemsetAsync((unsigned char*)d_ws + WS_BAR, 0, BAR_BYTES, stream) != hipSuccess) { fprintf(stderr, "kernel_launch: memset of the barrier words failed\n"); return; }
    Args a{};
    a.x = (const float*)d_in[0]; a.attn_norm = (const float*)d_in[1]; a.w_in = (const float*)d_in[2]; a.sinks = (const float*)d_in[3];
    a.out_norm_a = (const float*)d_in[4]; a.out_norm_b = (const float*)d_in[5]; a.w_out = (const float*)d_in[6]; a.ffn_norm = (const float*)d_in[7];
    a.w_gate = (const float*)d_in[8]; a.w_up = (const float*)d_in[9]; a.w_down = (const float*)d_in[10]; a.final_norm = (const float*)d_in[11];
    a.out = (float*)d_out; a.ws = (unsigned char*)d_ws; a.ph_lo = 0; a.ph_hi = N_PHASES;
    void* args[] = {&a};
    const hipError_t e = hipLaunchCooperativeKernel((const void*)fwd_megakernel, dim3(grid), dim3(NTHREADS), args, LDS_BYTES, stream);
    if (e != hipSuccess) fprintf(stderr, "kernel_launch: cooperative launch failed: %s (grid %d)\n", hipGetErrorString(e), grid);
}
```
